# Optimizing an MI355X kernel written in HIP

```python
import math
import jax, jax.numpy as jnp
from jax import lax
import numpy as np

D_MODEL = 1024
BATCH = 16
SEQ = 2048
DEPTH = 1
DEC_BATCH = 1
DEC_SEQ = 16384
PAST_LEN = 128

EPS = 1e-6
POOL_WINDOWS = (2, 4, 8, 16)
POOL_GROUPS = len(POOL_WINDOWS)
POOL_WIDTH = D_MODEL
POOL_GDIM = POOL_WIDTH // POOL_GROUPS
FOUR_GROUPS = 4
FOUR_WIDTH = D_MODEL // 2
FOUR_GDIM = FOUR_WIDTH // FOUR_GROUPS
ATTN_HEADS = 4
ATTN_WIDTH = D_MODEL // 2
HEAD_DIM = ATTN_WIDTH // ATTN_HEADS
N_MEM = 256
N_BRANCH = 3
IN_SPLITS = (POOL_WIDTH, POOL_WIDTH, FOUR_WIDTH, FOUR_WIDTH, ATTN_WIDTH, ATTN_WIDTH, N_BRANCH * D_MODEL)
IN_WIDTH = sum(IN_SPLITS)

kernel_name = "gated_pool_fourier_memxattn_encoder"


def rmsnorm(x, g):
    xf = x.astype(jnp.float32)
    r = lax.rsqrt(jnp.mean(xf * xf, axis=-1, keepdims=True) + EPS)
    return (xf * r * g.astype(jnp.float32)).astype(x.dtype)


def split_cols(z):
    offs = np.cumsum(IN_SPLITS)[:-1]
    return jnp.split(z, offs, axis=-1)


def pool_mixer(u, w_grp, scale):
    B, S, _ = u.shape
    ug = u.reshape(B, S, POOL_GROUPS, POOL_GDIM).astype(jnp.float32)
    cs = jnp.concatenate([jnp.zeros((B, 1, POOL_GROUPS, POOL_GDIM), jnp.float32), jnp.cumsum(ug, axis=1)], axis=1)
    t = np.arange(S)
    outs = []
    for g, w in enumerate(POOL_WINDOWS):
        half = w // 2
        lo = np.clip(t - half, 0, S)
        hi = np.clip(t + half, 0, S)
        cnt = jnp.asarray((hi - lo).astype(np.float32))[None, :, None]
        csg = cs[:, :, g]
        win_sum = jnp.take(csg, jnp.asarray(hi), axis=1) - jnp.take(csg, jnp.asarray(lo), axis=1)
        outs.append(win_sum / cnt - ug[:, :, g])
    p = jnp.stack(outs, axis=2).astype(u.dtype)
    y = jnp.einsum('bsgc,gcd->bsgd', p, w_grp).reshape(B, S, POOL_WIDTH)
    return y * scale


def fourier_mixer(u, w_grp):
    B, S, _ = u.shape
    uh = u.reshape(B, S, FOUR_GROUPS, FOUR_GDIM).astype(jnp.float32)
    f = jnp.fft.fftn(uh, axes=(1, 3), norm='ortho').real.astype(u.dtype)
    return jnp.einsum('bsgc,gcd->bsgd', f, w_grp).reshape(B, S, FOUR_WIDTH)


def memory_xattn(q, mem_n, w_kv):
    B, S, _ = q.shape
    kv = mem_n @ w_kv
    k, v = jnp.split(kv, 2, axis=-1)
    qh = q.reshape(B, S, ATTN_HEADS, HEAD_DIM)
    kh = k.reshape(B, N_MEM, ATTN_HEADS, HEAD_DIM)
    vh = v.reshape(B, N_MEM, ATTN_HEADS, HEAD_DIM)
    s = jnp.einsum('bshd,bmhd->bhsm', qh, kh).astype(jnp.float32) * (1.0 / math.sqrt(HEAD_DIM))
    p = jax.nn.softmax(s, axis=-1).astype(vh.dtype)
    o = jnp.einsum('bhsm,bmhd->bshd', p, vh)
    return o.reshape(B, S, ATTN_WIDTH)


def trunk(x, mem, norm_in, norm_mem, w_in, w_pool_grp, pool_scale, w_four_grp, w_kv,
          w_pool_out, w_four_out, w_attn_out, b_gate, w_o, norm_f):
    for l in range(DEPTH):
        xn = rmsnorm(x, norm_in[l])
        mn = rmsnorm(mem, norm_mem[l])
        pv, pg, fv, fg, q, ag, mg = split_cols(xn @ w_in[l])
        ya = (pool_mixer(pv, w_pool_grp[l], pool_scale[l]) * jax.nn.silu(pg)) @ w_pool_out[l]
        yb = (fourier_mixer(fv, w_four_grp[l]) * jax.nn.silu(fg)) @ w_four_out[l]
        yc = (memory_xattn(q, mn, w_kv[l]) * jax.nn.silu(ag)) @ w_attn_out[l]
        ga, gb, gc = jnp.split(jax.nn.sigmoid(mg + b_gate[l]), N_BRANCH, axis=-1)
        merged = ga * ya + gb * yb + gc * yc
        x = x + merged @ w_o[l]
    return rmsnorm(x, norm_f)


def setup_inputs(seed: int = 0) -> dict:
    key = jax.random.key(seed)
    ks = jax.random.split(key, 20)
    f32 = jnp.float32
    nrm = lambda k, shp, s: jax.random.normal(k, shp, f32) * s
    return {
        'x_prompt': nrm(ks[0], (BATCH, SEQ, D_MODEL), 1.0),
        'x_sample': nrm(ks[1], (DEC_BATCH, DEC_SEQ, D_MODEL), 1.0),
        'mem_prompt': nrm(ks[2], (BATCH, N_MEM, D_MODEL), 1.0),
        'mem_sample': nrm(ks[3], (DEC_BATCH, N_MEM, D_MODEL), 1.0),
        'norm_in': 1.0 + nrm(ks[4], (DEPTH, D_MODEL), 0.05),
        'norm_mem': 1.0 + nrm(ks[5], (DEPTH, D_MODEL), 0.05),
        'w_in': nrm(ks[6], (DEPTH, D_MODEL, IN_WIDTH), D_MODEL ** -0.5),
        'w_pool_grp': nrm(ks[7], (DEPTH, POOL_GROUPS, POOL_GDIM, POOL_GDIM), POOL_GDIM ** -0.5),
        'pool_scale': 1.0 + nrm(ks[8], (DEPTH, POOL_WIDTH), 0.05),
        'w_four_grp': nrm(ks[9], (DEPTH, FOUR_GROUPS, FOUR_GDIM, FOUR_GDIM), FOUR_GDIM ** -0.5),
        'w_kv': nrm(ks[10], (DEPTH, D_MODEL, 2 * ATTN_WIDTH), D_MODEL ** -0.5),
        'w_pool_out': nrm(ks[11], (DEPTH, POOL_WIDTH, D_MODEL), POOL_WIDTH ** -0.5),
        'w_four_out': nrm(ks[12], (DEPTH, FOUR_WIDTH, D_MODEL), FOUR_WIDTH ** -0.5),
        'w_attn_out': nrm(ks[13], (DEPTH, ATTN_WIDTH, D_MODEL), ATTN_WIDTH ** -0.5),
        'b_gate': nrm(ks[14], (DEPTH, N_BRANCH * D_MODEL), 0.1),
        'w_o': nrm(ks[15], (DEPTH, D_MODEL, D_MODEL), D_MODEL ** -0.5),
        'norm_f': 1.0 + nrm(ks[16], (D_MODEL,), 0.05),
    }


def reference(x_prompt, x_sample, mem_prompt, mem_sample, norm_in, norm_mem, w_in, w_pool_grp,
              pool_scale, w_four_grp, w_kv, w_pool_out, w_four_out, w_attn_out, b_gate, w_o, norm_f):
    y_prompt = trunk(x_prompt, mem_prompt, norm_in, norm_mem, w_in, w_pool_grp, pool_scale, w_four_grp,
                     w_kv, w_pool_out, w_four_out, w_attn_out, b_gate, w_o, norm_f)
    y_sample = trunk(x_sample, mem_sample, norm_in, norm_mem, w_in, w_pool_grp, pool_scale, w_four_grp,
                     w_kv, w_pool_out, w_four_out, w_attn_out, b_gate, w_o, norm_f)
    return (y_prompt, y_sample)
```

```cpp
#include <hip/hip_runtime.h>
#include <hip/hip_cooperative_groups.h>
#include <cstdio>
#include <cstdint>
namespace cg = cooperative_groups;

#ifndef MK_FUSED
#define MK_FUSED 0
#endif

#define LAS __attribute__((address_space(3)))
typedef unsigned short bf16_t;
typedef short bf16x8 __attribute__((ext_vector_type(8)));
typedef float f32x4 __attribute__((ext_vector_type(4)));
typedef float f32x2 __attribute__((ext_vector_type(2)));
typedef unsigned u32x4 __attribute__((ext_vector_type(4)));
typedef unsigned u32x2 __attribute__((ext_vector_type(2)));

constexpr int DM = 1024;
constexpr int MP = 16 * 2048, MS = 16384, MT = MP + MS;
constexpr int NSEQ = 17, NMEM = 256, MMEM = NSEQ * NMEM;
constexpr int INW = 7168;
constexpr float EPS = 1e-6f;
constexpr int NTHR = 512, NWAVES = 8;

constexpr size_t MiB = 1u << 20;
constexpr size_t WS_W1T = 1 * MiB;
constexpr size_t WS_WGT = 10 * MiB;
constexpr size_t WS_WPOT = 16 * MiB, WS_WFAT = 18 * MiB, WS_WOT = 20 * MiB, WS_WKVT = 22 * MiB;
constexpr size_t WS_MN = 24 * MiB;
constexpr size_t WS_KV = 33 * MiB;
constexpr size_t WS_XN = 48 * MiB;
constexpr size_t WS_PA = 144 * MiB;
constexpr size_t WS_FO = 240 * MiB;
constexpr size_t WS_AB = 336 * MiB;
constexpr size_t WS_Q = 432 * MiB;
constexpr size_t WS_END = 480 * MiB;
constexpr size_t OUT_PVF = 0, OUT_Y1 = 96 * MiB, OUT_STASH = 0;

constexpr int RING_BYTES = 131072;
constexpr int TAB_OFF = RING_BYTES + 1024;
constexpr int LDS_BYTES = 147456;

__device__ __forceinline__ unsigned f2bf(float f) { unsigned u = __builtin_bit_cast(unsigned, f); return (u + 0x7fffu + ((u >> 16) & 1u)) >> 16; }
__device__ __forceinline__ unsigned pk2(float lo, float hi) { return f2bf(lo) | (f2bf(hi) << 16); }
__device__ __forceinline__ float bflo(unsigned u) { return __builtin_bit_cast(float, u << 16); }
__device__ __forceinline__ float bfhi(unsigned u) { return __builtin_bit_cast(float, u & 0xffff0000u); }
__device__ __forceinline__ unsigned cvt_pk_bf16(float lo, float hi) { unsigned r; asm volatile("v_cvt_pk_bf16_f32 %0, %1, %2" : "=v"(r) : "v"(lo), "v"(hi)); return r; }
__device__ __forceinline__ float sigmoid_f(float v) { return __builtin_amdgcn_rcpf(1.0f + __expf(-v)); }
__device__ __forceinline__ float silu_f(float v) { return v * sigmoid_f(v); }
__device__ __forceinline__ float wave_sum(float v) {
#pragma unroll
    for (int o = 1; o < 64; o <<= 1) v += __shfl_xor(v, o);
    return v;
}
__device__ __forceinline__ float wave_max(float v) {
#pragma unroll
    for (int o = 1; o < 64; o <<= 1) v = fmaxf(v, __shfl_xor(v, o));
    return v;
}
#define LDS_WAIT() asm volatile("s_waitcnt lgkmcnt(0)" ::: "memory")

namespace pg8 {
constexpr int BM = 256, BK = 64, HALF = 128, HTB = HALF * BK * 2, STAGE_BYTES = 8 * HTB, NXCD = 8, WGM = 8;
constexpr int KP = 1024;
constexpr size_t TSTEP = (size_t)BM * KP * 2;
__device__ __forceinline__ int lds_byte(int r, int c) { const int st = (r >> 4) * 2 + (c >> 5), rr = r & 15, cc = c & 31, ob = rr * 64 + cc * 2; return st * 1024 + (ob ^ (((ob >> 9) & 1) << 5)); }
__device__ __forceinline__ void stage_rc(int b, int& R, int& C) { const int st = b / 1024, sb = b % 1024, swz = sb ^ (((sb >> 9) & 1) << 5); R = (st >> 1) * 16 + swz / 64; C = (st & 1) * 32 + (swz % 64) / 2; }
__device__ __forceinline__ int perm32(int rho) { const int n = rho >> 4, i = rho & 15; return 8 * (i >> 2) + 4 * n + (i & 3); }

struct Unit { const char* A; const char* B; int nt, pm, pn, seg; };

__device__ __forceinline__ void tile_order(int L, int nM, int nN, int& pm, int& pn) {
    const int nwg = nM * nN; int wgid = L;
    { const int q = nwg / NXCD, r = nwg % NXCD, xcd = wgid % NXCD, off = wgid / NXCD; wgid = (xcd < r ? xcd * (q + 1) : r * (q + 1) + (xcd - r) * q) + off; }
    const int nig = WGM * nN, gid = wgid / nig, fm = gid * WGM, gsz = (nM - fm) < WGM ? (nM - fm) : WGM;
    pm = fm + ((wgid % nig) % gsz); pn = (wgid % nig) / gsz;
}

template <class Epi, class Sched, bool ALIGN_EPI, bool SP2>
__device__ __forceinline__ void gemm_phase(LAS unsigned char* lds, const Sched& S, const Epi& E) {
    const int tid = threadIdx.x, wid = __builtin_amdgcn_readfirstlane(tid >> 6), lane = tid & 63, wr = wid >> 2, wc = wid & 3, fr = lane & 15, fq = lane >> 4;
    unsigned voffA[2], voffB[2];
#pragma unroll
    for (int i = 0; i < 2; ++i) { int R, C; stage_rc(tid * 16 + i * 8192, R, C); const int Rb = Epi::PERM ? ((R & ~31) + perm32(R & 31)) : R;
        voffA[i] = (unsigned)(R * KP + C) * 2u; voffB[i] = (unsigned)(Rb * KP + C) * 2u; }
    const size_t kstep = (size_t)(BK * 2);
    const size_t hstep = (size_t)HALF * KP * 2;
    const unsigned ldsw = (unsigned)wid * 1024u;
    const int aoff = lds_byte(wr * 64 + fr, fq * 8), boff = lds_byte(wc * 32 + fr, fq * 8);
#define PG8_SA(b, h) (((b) * 2 + (h)) * HTB)
#define PG8_SB(b, h) ((4 + (b) * 2 + (h)) * HTB)
#define PG8_STAGE(bufoff, gbase, voff) do { _Pragma("unroll") for (int _i = 0; _i < 2; ++_i) \
        __builtin_amdgcn_global_load_lds((const unsigned*)((const char*)(gbase) + (voff)[_i]), (LAS unsigned*)(lds + (bufoff) + ldsw + _i * 8192), 16, 0, 0); } while (0)
#define PG8_LDA(dst, b, h) do { _Pragma("unroll") for (int m = 0; m < 4; ++m) _Pragma("unroll") for (int k = 0; k < 2; ++k) dst[m][k] = *(const LAS bf16x8*)(lds + PG8_SA(b, h) + aoff + m * 2048 + k * 1024); } while (0)
#define PG8_LDB(dst, b, h) do { _Pragma("unroll") for (int n = 0; n < 2; ++n) _Pragma("unroll") for (int k = 0; k < 2; ++k) dst[n][k] = *(const LAS bf16x8*)(lds + PG8_SB(b, h) + boff + n * 2048 + k * 1024); } while (0)
#define PG8_MMA(ai, bj, At, Bt) do { __builtin_amdgcn_s_setprio(1); _Pragma("unroll") for (int m = 0; m < 4; ++m) _Pragma("unroll") for (int n = 0; n < 2; ++n) _Pragma("unroll") for (int k = 0; k < 2; ++k) \
        acc[ai][bj][m][n] = __builtin_amdgcn_mfma_f32_16x16x32_bf16(Bt[n][k], At[m][k], acc[ai][bj][m][n], 0, 0, 0); __builtin_amdgcn_s_setprio(0); } while (0)
#define PG8_WAIT_V(n) asm volatile("s_waitcnt vmcnt(" #n ")" ::: "memory")
#define PG8_WAIT_L(n) asm volatile("s_waitcnt lgkmcnt(" #n ")" ::: "memory")
#define PG8_BAR __builtin_amdgcn_s_barrier()
#define PG8_SCHED __builtin_amdgcn_sched_barrier(0)
    Unit cur, nxt; int ui = 0;
    if (!S.next(0, cur)) return;
    f32x4 acc[2][2][4][2];
#pragma unroll
    for (int a = 0; a < 2; ++a)
#pragma unroll
        for (int b = 0; b < 2; ++b)
#pragma unroll
            for (int m = 0; m < 4; ++m)
#pragma unroll
                for (int n = 0; n < 2; ++n) acc[a][b][m][n] = (f32x4){0.f, 0.f, 0.f, 0.f};
    bf16x8 At[4][2], B0[2][2], B1[2][2];
    const char* cA = cur.A; const char* cB = cur.B;
    if constexpr (SP2) {
        PG8_STAGE(PG8_SB(0, 0), cB, voffB); PG8_STAGE(PG8_SB(0, 1), cB + hstep, voffB); PG8_STAGE(PG8_SA(0, 0), cA, voffA); PG8_STAGE(PG8_SA(0, 1), cA + hstep, voffA);
        if (wr == 1) PG8_BAR;
        PG8_WAIT_V(2); PG8_BAR;
        PG8_STAGE(PG8_SB(1, 0), cB + kstep, voffB); PG8_STAGE(PG8_SA(1, 0), cA + kstep, voffA); PG8_STAGE(PG8_SB(1, 1), cB + hstep + kstep, voffB);
        PG8_WAIT_V(6); PG8_BAR;
    } else {
        PG8_STAGE(PG8_SB(0, 0), cB, voffB); PG8_STAGE(PG8_SA(0, 0), cA, voffA); PG8_STAGE(PG8_SB(0, 1), cB + hstep, voffB); PG8_STAGE(PG8_SA(0, 1), cA + hstep, voffA);
        if (wr == 1) PG8_BAR;
        PG8_WAIT_V(4); PG8_BAR;
        PG8_STAGE(PG8_SB(1, 0), cB + kstep, voffB); PG8_STAGE(PG8_SA(1, 0), cA + kstep, voffA); PG8_STAGE(PG8_SB(1, 1), cB + hstep + kstep, voffB);
        PG8_WAIT_V(6); PG8_BAR;
    }
    for (;;) {
        const bool has_next = S.next(ui + 1, nxt);
        const char* nA = has_next ? nxt.A : cA; const char* nB = has_next ? nxt.B : cB;
        const int nt = cur.nt;
        for (int t = 0; t < nt; t += 2) {
            const bool last = (t == nt - 2);
            const char* a1 = cA + (size_t)(t + 1) * kstep;
            const char* a2 = last ? nA : cA + (size_t)(t + 2) * kstep; const char* b2 = last ? nB : cB + (size_t)(t + 2) * kstep;
            const char* a3 = a2 + kstep; const char* b3 = b2 + kstep;
            if constexpr (SP2) {
            PG8_LDB(B0, 0, 0); PG8_LDB(B1, 0, 1); PG8_SCHED; PG8_LDA(At, 0, 0); PG8_STAGE(PG8_SA(1, 1), a1 + hstep, voffA);
            PG8_WAIT_V(8); PG8_WAIT_L(0); PG8_BAR; PG8_MMA(0, 0, At, B0); PG8_MMA(0, 1, At, B1); PG8_BAR; PG8_SCHED;
            PG8_LDA(At, 0, 1); PG8_STAGE(PG8_SB(0, 0), b2, voffB); PG8_STAGE(PG8_SB(0, 1), b2 + hstep, voffB); PG8_STAGE(PG8_SA(0, 0), a2, voffA);
            PG8_WAIT_V(8); PG8_WAIT_L(0); PG8_BAR; PG8_MMA(1, 0, At, B0); PG8_MMA(1, 1, At, B1); PG8_BAR; PG8_SCHED;
            PG8_LDB(B0, 1, 0); PG8_LDB(B1, 1, 1); PG8_SCHED; PG8_LDA(At, 1, 0); PG8_STAGE(PG8_SA(0, 1), a2 + hstep, voffA);
            PG8_WAIT_V(8); PG8_WAIT_L(0); PG8_BAR; PG8_MMA(0, 0, At, B0); PG8_MMA(0, 1, At, B1); PG8_BAR; PG8_SCHED;
            PG8_LDA(At, 1, 1); PG8_STAGE(PG8_SB(1, 0), b3, voffB); PG8_STAGE(PG8_SB(1, 1), b3 + hstep, voffB); PG8_STAGE(PG8_SA(1, 0), a3, voffA);
            PG8_WAIT_V(8); PG8_WAIT_L(0); PG8_BAR; PG8_MMA(1, 0, At, B0); PG8_MMA(1, 1, At, B1); PG8_BAR; PG8_SCHED;
            } else {
            PG8_LDB(B0, 0, 0); PG8_SCHED; PG8_LDA(At, 0, 0); PG8_STAGE(PG8_SA(1, 1), a1 + hstep, voffA);
            PG8_WAIT_L(8); PG8_BAR; PG8_WAIT_L(0); PG8_MMA(0, 0, At, B0); PG8_BAR; PG8_SCHED;
            PG8_LDB(B1, 0, 1); PG8_STAGE(PG8_SB(0, 0), b2, voffB);
            PG8_BAR; PG8_WAIT_L(0); PG8_MMA(0, 1, At, B1); PG8_BAR;
            PG8_LDA(At, 0, 1); PG8_STAGE(PG8_SA(0, 0), a2, voffA);
            PG8_BAR; PG8_WAIT_L(0); PG8_MMA(1, 0, At, B0); PG8_BAR; PG8_SCHED;
            PG8_STAGE(PG8_SB(0, 1), b2 + hstep, voffB);
            PG8_WAIT_V(6); PG8_BAR; PG8_MMA(1, 1, At, B1); PG8_BAR;
            PG8_LDB(B0, 1, 0); PG8_SCHED; PG8_LDA(At, 1, 0); PG8_STAGE(PG8_SA(0, 1), a2 + hstep, voffA);
            PG8_WAIT_L(8); PG8_BAR; PG8_WAIT_L(0); PG8_MMA(0, 0, At, B0); PG8_BAR; PG8_SCHED;
            PG8_LDB(B1, 1, 1); PG8_STAGE(PG8_SB(1, 0), b3, voffB);
            PG8_BAR; PG8_WAIT_L(0); PG8_MMA(0, 1, At, B1); PG8_BAR;
            PG8_LDA(At, 1, 1); PG8_STAGE(PG8_SA(1, 0), a3, voffA);
            PG8_BAR; PG8_WAIT_L(0); PG8_MMA(1, 0, At, B0); PG8_BAR; PG8_SCHED;
            PG8_STAGE(PG8_SB(1, 1), b3 + hstep, voffB);
            PG8_WAIT_V(6); PG8_BAR; PG8_MMA(1, 1, At, B1); PG8_BAR;
            }
        }
        if constexpr (ALIGN_EPI) { if (wr == 0) PG8_BAR; }
        E(acc, cur, wr, wc, fr, fq);
        if (!has_next) break;
#pragma unroll
        for (int a = 0; a < 2; ++a)
#pragma unroll
            for (int b = 0; b < 2; ++b)
#pragma unroll
                for (int m = 0; m < 4; ++m)
#pragma unroll
                    for (int n = 0; n < 2; ++n) acc[a][b][m][n] = (f32x4){0.f, 0.f, 0.f, 0.f};
        cur = nxt; cA = nA; cB = nB; ++ui;
        if constexpr (ALIGN_EPI) { if (wr == 1) PG8_BAR; }
    }
    PG8_WAIT_V(0);
    if constexpr (!ALIGN_EPI) { if (wr == 0) PG8_BAR; }
    PG8_BAR;
#undef PG8_SA
#undef PG8_SB
#undef PG8_STAGE
#undef PG8_LDA
#undef PG8_LDB
#undef PG8_MMA
#undef PG8_WAIT_V
#undef PG8_WAIT_L
#undef PG8_BAR
#undef PG8_SCHED
}
}
using pg8::Unit;

struct Ctx {
    LAS unsigned char* lds;
    int tid, lane, wave, G, bid;
    const float *xp, *xs, *memp, *mems, *norm_in, *norm_mem, *w_in, *w_pool_grp, *pool_scale, *w_four_grp, *w_kv, *w_pool_out, *w_four_out, *w_attn_out, *b_gate, *w_o, *norm_f;
    float* out;
    bf16_t *W1T, *WGT, *WPOT, *WFAT, *WOT, *WKVT, *MN, *KV, *XN, *PA, *FO, *AB, *Q, *PVF, *Y1, *MERGED;
    unsigned char* stash;
};

struct SchedP1 {
    int G, c; const char *XN, *W1T, *MN, *WKVT;
    __device__ __forceinline__ bool next(int i, Unit& u) const {
        int L = i * G + c; u.nt = 16;
        if (L < 192 * 18) { pg8::tile_order(L, 192, 18, u.pm, u.pn); u.A = XN + (size_t)u.pm * pg8::TSTEP; u.B = W1T + (size_t)u.pn * pg8::TSTEP; u.seg = 0; return true; }
        L -= 192 * 18; if (L >= 17 * 4) return false;
        u.pm = L % 17; u.pn = L / 17; u.A = MN + (size_t)u.pm * pg8::TSTEP; u.B = WKVT + (size_t)u.pn * pg8::TSTEP; u.seg = 1; return true;
    }
};
struct EpiP1 {
    static constexpr bool PERM = true;
    bf16_t *PVF, *SPG, *AB, *FO, *Q, *KV;
    __device__ __forceinline__ void operator()(const f32x4 (&acc)[2][2][4][2], const Unit& u, int wr, int wc, int fr, int fq) const {
        bf16_t* base; int ld, colt, act; const int pn = u.pn;
        if (u.seg == 1) { base = KV; ld = 1024; colt = pn * 256; act = 0; }
        else if (pn < 4) { base = PVF; ld = 1024; colt = pn * 256; act = 0; }
        else if (pn < 8) { base = SPG; ld = 1024; colt = (pn - 4) * 256; act = 1; }
        else if (pn < 12) { base = AB; ld = 1024; colt = (pn - 8) * 256; act = 0; }
        else if (pn < 14) { base = FO; ld = 1024; colt = (pn - 12) * 256; act = 1; }
        else if (pn < 16) { base = Q; ld = 512; colt = (pn - 14) * 256; act = 0; }
        else { base = FO; ld = 1024; colt = 512 + (pn - 16) * 256; act = 1; }
        const int row0 = u.pm * 256 + wr * 64 + fr, col0 = colt + wc * 32 + 8 * fq;
#pragma unroll
        for (int ai = 0; ai < 2; ++ai)
#pragma unroll
            for (int m = 0; m < 4; ++m) { bf16_t* rowp = base + (size_t)(row0 + ai * 128 + m * 16) * ld + col0;
#pragma unroll
                for (int bj = 0; bj < 2; ++bj) { f32x4 v0 = acc[ai][bj][m][0], v1 = acc[ai][bj][m][1];
                    if (act) {
#pragma unroll
                        for (int j = 0; j < 4; ++j) { v0[j] = silu_f(v0[j]); v1[j] = silu_f(v1[j]); } }
                    u32x4 w; w.x = cvt_pk_bf16(v0[0], v0[1]); w.y = cvt_pk_bf16(v0[2], v0[3]); w.z = cvt_pk_bf16(v1[0], v1[1]); w.w = cvt_pk_bf16(v1[2], v1[3]);
                    *(u32x4*)(rowp + bj * 128) = w; } }
    }
};
struct SchedP3 {
    int G, c; const char *PA, *XN, *FO, *WPOT, *WGT, *WFAT;
    __device__ __forceinline__ bool next(int i, Unit& u) const {
        const int ti = i / 6, seg = i - 6 * ti, L = ti * G + c; if (L >= 192 * 4) return false;
        pg8::tile_order(L, 192, 4, u.pm, u.pn); u.seg = seg;
        const size_t am = (size_t)u.pm * pg8::TSTEP, bn = (size_t)u.pn * pg8::TSTEP;
        if (seg == 0) { u.A = PA + am; u.B = WPOT + bn; u.nt = 16; }
        else if (seg == 2) { u.A = FO + am; u.B = WFAT + bn; u.nt = 8; }
        else if (seg == 4) { u.A = FO + am + 1024; u.B = WFAT + bn + 1024; u.nt = 8; }
        else { u.A = XN + am; u.B = WGT + (size_t)(4 * (seg >> 1) + u.pn) * pg8::TSTEP; u.nt = 16; }
        return true;
    }
};
struct EpiP3 {
    static constexpr bool PERM = true;
    unsigned char* stash; const float* bgate; bf16_t* MERGED;
    __device__ __forceinline__ void operator()(const f32x4 (&acc)[2][2][4][2], const Unit& u, int wr, int wc, int fr, int fq) const {
        const int tid = threadIdx.x, seg = u.seg;
        const unsigned toff = (unsigned)tid * 16u; const __amdgpu_buffer_rsrc_t srs = __builtin_amdgcn_make_buffer_rsrc((void*)stash, (short)0, 262144, 0x00020000);
        if ((seg & 1) == 0) {
#pragma unroll
            for (int ai = 0; ai < 2; ++ai)
#pragma unroll
                for (int bj = 0; bj < 2; ++bj)
#pragma unroll
                    for (int m = 0; m < 4; ++m) { const f32x4 v0 = acc[ai][bj][m][0], v1 = acc[ai][bj][m][1];
                        u32x4 w; w.x = cvt_pk_bf16(v0[0], v0[1]); w.y = cvt_pk_bf16(v0[2], v0[3]); w.z = cvt_pk_bf16(v1[0], v1[1]); w.w = cvt_pk_bf16(v1[2], v1[3]);
                        __builtin_amdgcn_raw_buffer_store_b128(w, srs, toff, ((ai * 2 + bj) * 4 + m) * 8192, 0); }
        } else {
            const int bcol0 = (seg >> 1) * 1024 + u.pn * 256 + wc * 32 + 8 * fq;
            const int row0 = u.pm * 256 + wr * 64 + fr, col0 = u.pn * 256 + wc * 32 + 8 * fq;
#pragma unroll
            for (int bj = 0; bj < 2; ++bj) {
                const f32x4 b0 = *(const f32x4*)(bgate + bcol0 + bj * 128), b1 = *(const f32x4*)(bgate + bcol0 + bj * 128 + 4);
#pragma unroll
                for (int ai = 0; ai < 2; ++ai)
#pragma unroll
                    for (int m = 0; m < 4; ++m) { const int j = (ai * 2 + bj) * 4 + m;
                        const u32x4 yv = __builtin_amdgcn_raw_buffer_load_b128(srs, toff, j * 8192, 0);
                        const f32x4 a0 = acc[ai][bj][m][0] + b0, a1 = acc[ai][bj][m][1] + b1;
                        float r[8];
                        r[0] = sigmoid_f(a0[0]) * bflo(yv.x); r[1] = sigmoid_f(a0[1]) * bfhi(yv.x); r[2] = sigmoid_f(a0[2]) * bflo(yv.y); r[3] = sigmoid_f(a0[3]) * bfhi(yv.y);
                        r[4] = sigmoid_f(a1[0]) * bflo(yv.z); r[5] = sigmoid_f(a1[1]) * bfhi(yv.z); r[6] = sigmoid_f(a1[2]) * bflo(yv.w); r[7] = sigmoid_f(a1[3]) * bfhi(yv.w);
                        if (seg >= 3) { const u32x4 mv = __builtin_amdgcn_raw_buffer_load_b128(srs, toff, 131072 + j * 8192, 0);
                            r[0] += bflo(mv.x); r[1] += bfhi(mv.x); r[2] += bflo(mv.y); r[3] += bfhi(mv.y); r[4] += bflo(mv.z); r[5] += bfhi(mv.z); r[6] += bflo(mv.w); r[7] += bfhi(mv.w); }
                        u32x4 w; w.x = cvt_pk_bf16(r[0], r[1]); w.y = cvt_pk_bf16(r[2], r[3]); w.z = cvt_pk_bf16(r[4], r[5]); w.w = cvt_pk_bf16(r[6], r[7]);
                        if (seg < 5) __builtin_amdgcn_raw_buffer_store_b128(w, srs, toff, 131072 + j * 8192, 0);
                        else *(u32x4*)(MERGED + (size_t)(row0 + ai * 128 + m * 16) * 1024 + col0 + bj * 128) = w;
                        if (m & 1) asm volatile("" ::: "memory"); }
            }
        }
    }
};
struct SchedP4 {
    int G, c; const char *MERGED, *WOT;
    __device__ __forceinline__ bool next(int i, Unit& u) const {
        const int L = i * G + c; if (L >= 192 * 4) return false;
        pg8::tile_order(L, 192, 4, u.pm, u.pn); u.A = MERGED + (size_t)u.pm * pg8::TSTEP; u.B = WOT + (size_t)u.pn * pg8::TSTEP; u.nt = 16; u.seg = 0; return true;
    }
};
struct EpiP4 {
    static constexpr bool PERM = false;
    const float *xp, *xs; float* out;
    __device__ __forceinline__ void operator()(const f32x4 (&acc)[2][2][4][2], const Unit& u, int wr, int wc, int fr, int fq) const {
        const int row0 = u.pm * 256 + wr * 64 + fr, col0 = u.pn * 256 + wc * 32 + 4 * fq;
        const float* xb = (u.pm < MP / 256) ? xp : xs - (size_t)MP * DM;
#pragma unroll
        for (int ai = 0; ai < 2; ++ai)
#pragma unroll
            for (int m = 0; m < 4; ++m) { const size_t off = (size_t)(row0 + ai * 128 + m * 16) * DM + col0;
#pragma unroll
                for (int bj = 0; bj < 2; ++bj)
#pragma unroll
                    for (int n = 0; n < 2; ++n) { const f32x4 xv = *(const f32x4*)(xb + off + bj * 128 + n * 16); *(f32x4*)(out + off + bj * 128 + n * 16) = xv + acc[ai][bj][m][n]; }
                asm volatile("" ::: "memory"); }
    }
};

__device__ __forceinline__ void transpose_item(const float* W, int ldw, bf16_t* WT, int nblk, LAS float* scr, int item, int lane) {
    const int kb = item / nblk, nb = item % nblk, k0 = 64 * kb, n0 = 32 * nb;
#pragma unroll 8
    for (int i = 0; i < 32; ++i) { const int kk = 2 * i + (lane >> 5); scr[kk * 33 + (lane & 31)] = W[(size_t)(k0 + kk) * ldw + n0 + (lane & 31)]; }
    LDS_WAIT(); asm volatile("" ::: "memory");
    const int c = lane & 7;
#pragma unroll
    for (int j = 0; j < 4; ++j) { const int n = (lane >> 3) + 8 * j; const LAS float* s = scr + (8 * c) * 33 + n;
        u32x4 o; o.x = pk2(s[0 * 33], s[1 * 33]); o.y = pk2(s[2 * 33], s[3 * 33]); o.z = pk2(s[4 * 33], s[5 * 33]); o.w = pk2(s[6 * 33], s[7 * 33]);
        *(u32x4*)(WT + (size_t)(n0 + n) * 1024 + k0 + 8 * c) = o; }
    LDS_WAIT(); asm volatile("" ::: "memory");
}
__device__ __forceinline__ void rms_row_to_bf16(const float* xrow, const float* gain, bf16_t* orow, int lane) {
    const f32x4* xr = (const f32x4*)xrow + lane; const f32x4* gr = (const f32x4*)gain + lane;
    f32x4 v[4]; float s = 0.f;
#pragma unroll
    for (int j = 0; j < 4; ++j) { v[j] = xr[64 * j]; s += (v[j].x * v[j].x + v[j].y * v[j].y) + (v[j].z * v[j].z + v[j].w * v[j].w); }
    const float r = 1.0f / sqrtf(wave_sum(s) * (1.f / DM) + EPS);
    u32x2* o8 = (u32x2*)orow + lane;
#pragma unroll
    for (int j = 0; j < 4; ++j) { const f32x4 g = gr[64 * j]; u32x2 w; w.x = pk2(v[j].x * r * g.x, v[j].y * r * g.y); w.y = pk2(v[j].z * r * g.z, v[j].w * r * g.w); o8[64 * j] = w; }
}
__device__ __forceinline__ void fold_item(const Ctx& F, int item) {
    LAS float* As = (LAS float*)F.lds;
    LAS float* Bs = (LAS float*)(F.lds + 16384);
    LAS float* Ts = (LAS float*)(F.lds + 32768);
    const LAS f32x2* tab = (const LAS f32x2*)(F.lds + TAB_OFF);
    const int tid = F.tid, tk = tid & 63, tj = tid >> 6;
    float acc[8];
#pragma unroll
    for (int j = 0; j < 8; ++j) acc[j] = 0.f;
    if (item < 256) {
        const int g = item >> 6, k0 = ((item >> 2) & 15) * 64, j0 = (item & 3) * 64;
        for (int c0 = 0; c0 < 256; c0 += 32) {
            __syncthreads();
#pragma unroll
            for (int i = 0; i < 4; ++i) { const int idx = tid + 512 * i; { const int kk = idx >> 5, cc = idx & 31; As[kk * 33 + cc] = F.w_in[(size_t)(k0 + kk) * INW + g * 256 + c0 + cc]; }
                { const int cc = idx >> 6, jj = idx & 63; Bs[cc * 64 + jj] = F.w_pool_grp[(size_t)(g * 256 + c0 + cc) * 256 + j0 + jj]; } }
            __syncthreads();
#pragma unroll 8
            for (int cc = 0; cc < 32; ++cc) { const float a = As[tk * 33 + cc];
#pragma unroll
                for (int j = 0; j < 8; ++j) acc[j] += a * Bs[cc * 64 + tj * 8 + j]; }
        }
#pragma unroll
        for (int j = 0; j < 8; ++j) { const int n = g * 256 + j0 + tj * 8 + j; F.W1T[(size_t)n * 1024 + k0 + tk] = (bf16_t)f2bf(acc[j] * F.pool_scale[n]); }
    } else {
        const int it = item - 256, g = it >> 6, sn = (it >> 5) & 1, k0 = ((it >> 1) & 15) * 64, j0 = (it & 1) * 64;
        __syncthreads();
        { const int c = tid & 127, jq = tid >> 7; float t[16];
#pragma unroll
            for (int j = 0; j < 16; ++j) t[j] = 0.f;
            for (int d = 0; d < 128; ++d) { const f32x2 cs = tab[(c * d) & 127]; const float w = sn ? cs.y : cs.x;
                const f32x4* wp = (const f32x4*)(F.w_four_grp + (size_t)(g * 128 + d) * 128 + j0 + jq * 16);
#pragma unroll
                for (int q = 0; q < 4; ++q) { const f32x4 x = wp[q]; t[4 * q] += w * x.x; t[4 * q + 1] += w * x.y; t[4 * q + 2] += w * x.z; t[4 * q + 3] += w * x.w; } }
#pragma unroll
            for (int j = 0; j < 16; ++j) Ts[c * 64 + jq * 16 + j] = t[j] * 0.08838834764831845f; }
        for (int c0 = 0; c0 < 128; c0 += 32) {
            __syncthreads();
#pragma unroll
            for (int i = 0; i < 4; ++i) { const int idx = tid + 512 * i; const int kk = idx >> 5, cc = idx & 31; As[kk * 33 + cc] = F.w_in[(size_t)(k0 + kk) * INW + 2048 + g * 128 + c0 + cc]; }
            __syncthreads();
#pragma unroll 8
            for (int cc = 0; cc < 32; ++cc) { const float a = As[tk * 33 + cc];
#pragma unroll
                for (int j = 0; j < 8; ++j) acc[j] += a * Ts[(c0 + cc) * 64 + tj * 8 + j]; }
        }
#pragma unroll
        for (int j = 0; j < 8; ++j) { const int n = 2048 + sn * 512 + g * 128 + j0 + tj * 8 + j; F.W1T[(size_t)n * 1024 + k0 + tk] = (bf16_t)f2bf(acc[j]); }
    }
    __syncthreads();
}
__device__ __forceinline__ void p0_prologue(const Ctx& F) {
    for (int it = F.bid; it < 512; it += F.G) fold_item(F, it);
    __syncthreads();
    LAS float* scr = (LAS float*)(F.lds + F.wave * 16384);
    const int gw = F.bid * NWAVES + F.wave, NGW = F.G * NWAVES;
    constexpr int I0 = 16 * 32, I1 = 16 * 16, I4 = 16 * 96, I5 = 16 * 32, I6 = 8 * 32;
    constexpr int NITEMS = I0 + 3 * I1 + I4 + I5 + 2 * I6 + 2 * I5;
    for (int it = gw; it < NITEMS; it += NGW) {
        int r = it;
        if (r < I0) { transpose_item(F.w_in + 1024, INW, F.W1T + (size_t)1024 * 1024, 32, scr, r, F.lane); continue; } r -= I0;
        if (r < I1) { transpose_item(F.w_in + 2560, INW, F.W1T + (size_t)3072 * 1024, 16, scr, r, F.lane); continue; } r -= I1;
        if (r < I1) { transpose_item(F.w_in + 3072, INW, F.W1T + (size_t)3584 * 1024, 16, scr, r, F.lane); continue; } r -= I1;
        if (r < I1) { transpose_item(F.w_in + 3584, INW, F.W1T + (size_t)4096 * 1024, 16, scr, r, F.lane); continue; } r -= I1;
        if (r < I4) { transpose_item(F.w_in + 4096, INW, F.WGT, 96, scr, r, F.lane); continue; } r -= I4;
        if (r < I5) { transpose_item(F.w_pool_out, 1024, F.WPOT, 32, scr, r, F.lane); continue; } r -= I5;
        if (r < I6) { transpose_item(F.w_four_out, 1024, F.WFAT, 32, scr, r, F.lane); continue; } r -= I6;
        if (r < I6) { transpose_item(F.w_attn_out, 1024, F.WFAT + 512, 32, scr, r, F.lane); continue; } r -= I6;
        if (r < I5) { transpose_item(F.w_o, 1024, F.WOT, 32, scr, r, F.lane); continue; } r -= I5;
        transpose_item(F.w_kv, 1024, F.WKVT, 32, scr, r, F.lane);
    }
    for (int m = gw; m < MT + MMEM; m += NGW) {
        if (m < MP) rms_row_to_bf16(F.xp + (size_t)m * DM, F.norm_in, F.XN + (size_t)m * DM, F.lane);
        else if (m < MT) rms_row_to_bf16(F.xs + (size_t)(m - MP) * DM, F.norm_in, F.XN + (size_t)m * DM, F.lane);
        else { const int r = m - MT; const float* src = r < 16 * NMEM ? F.memp + (size_t)r * DM : F.mems + (size_t)(r - 16 * NMEM) * DM; rms_row_to_bf16(src, F.norm_mem, F.MN + (size_t)r * DM, F.lane); }
    }
}

__device__ __forceinline__ void seq_of_row(int row, int& r0, int& S) { if (row < MP) { r0 = row & ~2047; S = 2048; } else { r0 = MP; S = MS; } }
__device__ __forceinline__ void pool_phase(const Ctx& F) {
    const long total = (long)MT * 128;
    for (long it = (long)F.bid * NTHR + F.tid; it < total; it += (long)F.G * NTHR) {
        const int row = (int)(it >> 7), ch = (int)(it & 127), col = ch * 8, g = ch >> 5, half = 1 << g;
        int r0, S; seq_of_row(row, r0, S);
        const int t = row - r0, lo = t - half < 0 ? 0 : t - half, hi = t + half > S ? S : t + half;
        float s[8];
#pragma unroll
        for (int j = 0; j < 8; ++j) s[j] = 0.f;
        for (int i = lo; i < hi; ++i) { const u32x4 v = *(const u32x4*)(F.PVF + (size_t)(r0 + i) * 1024 + col);
            s[0] += bflo(v.x); s[1] += bfhi(v.x); s[2] += bflo(v.y); s[3] += bfhi(v.y); s[4] += bflo(v.z); s[5] += bfhi(v.z); s[6] += bflo(v.w); s[7] += bfhi(v.w); }
        const float inv = 1.0f / (float)(hi - lo);
        const u32x4 me = *(const u32x4*)(F.PVF + (size_t)row * 1024 + col); const u32x4 gt = *(const u32x4*)(F.PA + (size_t)row * 1024 + col);
        u32x4 o;
        o.x = pk2((s[0] * inv - bflo(me.x)) * bflo(gt.x), (s[1] * inv - bfhi(me.x)) * bfhi(gt.x));
        o.y = pk2((s[2] * inv - bflo(me.y)) * bflo(gt.y), (s[3] * inv - bfhi(me.y)) * bfhi(gt.y));
        o.z = pk2((s[4] * inv - bflo(me.z)) * bflo(gt.z), (s[5] * inv - bfhi(me.z)) * bfhi(gt.z));
        o.w = pk2((s[6] * inv - bflo(me.w)) * bflo(gt.w), (s[7] * inv - bfhi(me.w)) * bfhi(gt.w));
        *(u32x4*)(F.PA + (size_t)row * 1024 + col) = o;
    }
}
__device__ __forceinline__ void dft1_phase(const Ctx& F) {
    const LAS f32x2* tab = (const LAS f32x2*)(F.lds + TAB_OFF);
    for (int it = F.bid; it < 16384 + 8192; it += F.G) {
        int seq, s2, head, chk, N1, r0, S, sh;
        if (it < 16384) { seq = it >> 10; const int r = it & 1023; s2 = r >> 3; head = (r >> 1) & 3; chk = r & 1; N1 = 16; r0 = seq * 2048; S = 2048; sh = 3; }
        else { const int r = it - 16384; seq = 16; s2 = r >> 6; head = (r >> 4) & 3; chk = r & 15; N1 = 128; r0 = MP; S = MS; sh = 0; }
        const int k1 = chk * 8 + (F.tid >> 6), col = head * 128 + 2 * (F.tid & 63);
        float yr0 = 0.f, yr1 = 0.f, yi0 = 0.f, yi1 = 0.f;
        for (int s1 = 0; s1 < N1; ++s1) {
            const size_t ro = (size_t)(r0 + 128 * s1 + s2) * 1024 + col;
            const unsigned av = *(const unsigned*)(F.AB + ro), bv = *(const unsigned*)(F.AB + ro + 512);
            const f32x2 cs = tab[((k1 * s1) << sh) & 127];
            const float a0 = bflo(av), a1 = bfhi(av), b0 = bflo(bv), b1 = bfhi(bv);
            yr0 += cs.x * a0 - cs.y * b0; yi0 += cs.y * a0 + cs.x * b0;
            yr1 += cs.x * a1 - cs.y * b1; yi1 += cs.y * a1 + cs.x * b1;
        }
        float tc, ts; { const float ang = 2.0f * (float)(k1 * s2) / (float)S; ts = sinpif(ang); tc = cospif(ang); }
        const float sc = N1 == 16 ? 0.25f : 0.08838834764831845f; tc *= sc; ts *= sc;
        const size_t wo = (size_t)(r0 + 128 * k1 + s2) * 1024 + col;
        *(unsigned*)(F.Y1 + wo) = pk2(yr0 * tc - yi0 * ts, yr1 * tc - yi1 * ts);
        *(unsigned*)(F.Y1 + wo + 512) = pk2(yr0 * ts + yi0 * tc, yr1 * ts + yi1 * tc);
    }
}
__device__ __forceinline__ void dft2_phase(const Ctx& F) {
    const LAS f32x2* tab = (const LAS f32x2*)(F.lds + TAB_OFF);
    for (int it = F.bid; it < 16384 + 8192; it += F.G) {
        int seq, k1, head, chk, N1, r0;
        if (it < 16384) { seq = it >> 10; const int r = it & 1023; k1 = r >> 6; head = (r >> 4) & 3; chk = r & 15; N1 = 16; r0 = seq * 2048; }
        else { const int r = it - 16384; seq = 16; k1 = r >> 6; head = (r >> 4) & 3; chk = r & 15; N1 = 128; r0 = MP; }
        const int k2 = chk * 8 + (F.tid >> 6), col = head * 128 + 2 * (F.tid & 63);
        float f0 = 0.f, f1 = 0.f;
        for (int s2 = 0; s2 < 128; ++s2) {
            const size_t ro = (size_t)(r0 + 128 * k1 + s2) * 1024 + col;
            const unsigned rv = *(const unsigned*)(F.Y1 + ro), iv = *(const unsigned*)(F.Y1 + ro + 512);
            const f32x2 cs = tab[(k2 * s2) & 127];
            f0 += cs.x * bflo(rv) - cs.y * bflo(iv); f1 += cs.x * bfhi(rv) - cs.y * bfhi(iv);
        }
        const size_t wo = (size_t)(r0 + k1 + N1 * k2) * 1024 + col;
        const unsigned gt = *(const unsigned*)(F.FO + wo);
        *(unsigned*)(F.FO + wo) = pk2(f0 * 0.08838834764831845f * bflo(gt), f1 * 0.08838834764831845f * bfhi(gt));
    }
}
__device__ __forceinline__ void attn_phase_simple(const Ctx& F) {
    const int gw = F.bid * NWAVES + F.wave, NGW = F.G * NWAVES, lane = F.lane;
    for (int it = gw; it < MT * 4; it += NGW) {
        const int row = it >> 2, h = it & 3, seq = row < MP ? row >> 11 : 16;
        const bf16_t* q = F.Q + (size_t)row * 512 + h * 128;
        const bf16_t* Kb = F.KV + (size_t)(seq * NMEM) * 1024 + h * 128;
        const bf16_t* Vb = Kb + 512;
        float s[4] = {0.f, 0.f, 0.f, 0.f};
        for (int d = 0; d < 128; d += 8) {
            const u32x4 qv = *(const u32x4*)(q + d);
            const float q0 = bflo(qv.x), q1 = bfhi(qv.x), q2 = bflo(qv.y), q3 = bfhi(qv.y), q4 = bflo(qv.z), q5 = bfhi(qv.z), q6 = bflo(qv.w), q7 = bfhi(qv.w);
#pragma unroll
            for (int i = 0; i < 4; ++i) { const u32x4 kv = *(const u32x4*)(Kb + (size_t)(lane + 64 * i) * 1024 + d);
                s[i] += q0 * bflo(kv.x) + q1 * bfhi(kv.x) + q2 * bflo(kv.y) + q3 * bfhi(kv.y) + q4 * bflo(kv.z) + q5 * bfhi(kv.z) + q6 * bflo(kv.w) + q7 * bfhi(kv.w); }
        }
        const float scale = 0.08838834764831845f;
#pragma unroll
        for (int i = 0; i < 4; ++i) s[i] *= scale;
        const float mx = wave_max(fmaxf(fmaxf(s[0], s[1]), fmaxf(s[2], s[3])));
        float p[4], l = 0.f;
#pragma unroll
        for (int i = 0; i < 4; ++i) { p[i] = __expf(s[i] - mx); l += p[i]; }
        l = wave_sum(l);
        float o0 = 0.f, o1 = 0.f;
#pragma unroll
        for (int i = 0; i < 4; ++i)
            for (int kk = 0; kk < 64; ++kk) { const float pk = __shfl(p[i], kk); const unsigned vv = *(const unsigned*)(Vb + (size_t)(64 * i + kk) * 1024 + 2 * lane); o0 += pk * bflo(vv); o1 += pk * bfhi(vv); }
        const float rl = 1.0f / l;
        unsigned* dst = (unsigned*)(F.FO + (size_t)row * 1024 + 512 + h * 128 + 2 * lane);
        const unsigned gt = *dst;
        *dst = pk2(o0 * rl * bflo(gt), o1 * rl * bfhi(gt));
    }
}
__device__ __forceinline__ void final_norm_phase(const Ctx& F) {
    const int gw = F.bid * NWAVES + F.wave, NGW = F.G * NWAVES;
    for (int m = gw; m < MT; m += NGW) {
        f32x4* xr = (f32x4*)(F.out + (size_t)m * DM) + F.lane; const f32x4* gr = (const f32x4*)F.norm_f + F.lane;
        f32x4 v[4]; float s = 0.f;
#pragma unroll
        for (int j = 0; j < 4; ++j) { v[j] = xr[64 * j]; s += (v[j].x * v[j].x + v[j].y * v[j].y) + (v[j].z * v[j].z + v[j].w * v[j].w); }
        const float r = 1.0f / sqrtf(wave_sum(s) * (1.f / DM) + EPS);
#pragma unroll
        for (int j = 0; j < 4; ++j) { const f32x4 g = gr[64 * j]; xr[64 * j] = v[j] * r * g; }
    }
}

struct Args { const float* in[17]; float* out; unsigned char* ws; int ph_lo, ph_hi; };
constexpr int N_PHASES = 7;
__global__ void __launch_bounds__(NTHR, 2) fwd(Args args) {
    extern __shared__ __attribute__((aligned(16))) unsigned char lds_[];
    cg::grid_group grid = cg::this_grid();
    Ctx F;
    F.lds = (LAS unsigned char*)lds_;
    F.tid = threadIdx.x; F.lane = F.tid & 63; F.wave = __builtin_amdgcn_readfirstlane(F.tid >> 6); F.G = gridDim.x; F.bid = blockIdx.x;
    F.xp = args.in[0]; F.xs = args.in[1]; F.memp = args.in[2]; F.mems = args.in[3]; F.norm_in = args.in[4]; F.norm_mem = args.in[5]; F.w_in = args.in[6]; F.w_pool_grp = args.in[7];
    F.pool_scale = args.in[8]; F.w_four_grp = args.in[9]; F.w_kv = args.in[10]; F.w_pool_out = args.in[11]; F.w_four_out = args.in[12]; F.w_attn_out = args.in[13]; F.b_gate = args.in[14];
    F.w_o = args.in[15]; F.norm_f = args.in[16]; F.out = args.out;
    unsigned char* ws = args.ws; unsigned char* ob = (unsigned char*)args.out;
    F.W1T = (bf16_t*)(ws + WS_W1T); F.WGT = (bf16_t*)(ws + WS_WGT); F.WPOT = (bf16_t*)(ws + WS_WPOT); F.WFAT = (bf16_t*)(ws + WS_WFAT); F.WOT = (bf16_t*)(ws + WS_WOT); F.WKVT = (bf16_t*)(ws + WS_WKVT);
    F.MN = (bf16_t*)(ws + WS_MN); F.KV = (bf16_t*)(ws + WS_KV); F.XN = (bf16_t*)(ws + WS_XN); F.PA = (bf16_t*)(ws + WS_PA); F.FO = (bf16_t*)(ws + WS_FO); F.AB = (bf16_t*)(ws + WS_AB);
    F.Q = (bf16_t*)(ws + WS_Q); F.PVF = (bf16_t*)(ob + OUT_PVF); F.Y1 = (bf16_t*)(ob + OUT_Y1); F.MERGED = (bf16_t*)(ws + WS_AB);
    F.stash = ob + OUT_STASH + (size_t)blockIdx.x * 262144;
    if (F.tid < 128) { LAS f32x2* tab = (LAS f32x2*)(F.lds + TAB_OFF); f32x2 v; v.x = cospif((float)F.tid * (1.0f / 64.0f)); v.y = sinpif((float)F.tid * (1.0f / 64.0f)); tab[F.tid] = v; }
    __syncthreads();
    const int lo = args.ph_lo, hi = args.ph_hi;
#define IN(k) (lo <= (k) && (k) < hi)
#define SEAM(k) do { if (IN(k) && IN((k) + 1)) grid.sync(); } while (0)
    if (IN(0)) { p0_prologue(F); }
    SEAM(0);
    if (IN(1)) {
        SchedP1 S{F.G, F.bid, (const char*)F.XN, (const char*)F.W1T, (const char*)F.MN, (const char*)F.WKVT};
        EpiP1 E{F.PVF, F.PA, F.AB, F.FO, F.Q, F.KV};
        pg8::gemm_phase<EpiP1, SchedP1, true, true>(F.lds, S, E);
    }
    SEAM(1);
    if (IN(2)) { pool_phase(F); dft1_phase(F); attn_phase_simple(F); }
    SEAM(2);
    if (IN(3)) { dft2_phase(F); }
    SEAM(3);
    if (IN(4)) {
        SchedP3 S{F.G, F.bid, (const char*)F.PA, (const char*)F.XN, (const char*)F.FO, (const char*)F.WPOT, (const char*)F.WGT, (const char*)F.WFAT};
        EpiP3 E{F.stash, F.b_gate, F.MERGED};
        pg8::gemm_phase<EpiP3, SchedP3, true, true>(F.lds, S, E);
    }
    SEAM(4);
    if (IN(5)) {
        SchedP4 S{F.G, F.bid, (const char*)F.MERGED, (const char*)F.WOT};
        EpiP4 E{F.xp, F.xs, F.out};
        pg8::gemm_phase<EpiP4, SchedP4, true, true>(F.lds, S, E);
    }
    SEAM(5);
    if (IN(6)) { final_norm_phase(F); }
#undef IN
#undef SEAM
}

extern "C" void kernel_launch(void* const* d_in, const int* in_sizes, int n_in, void* d_out, int out_size, void* d_ws, size_t ws_size, hipStream_t stream) {
    static int grid = 0;
    if (grid == 0) {
        if (n_in != 17 || in_sizes[0] != MP * DM || in_sizes[1] != MS * DM || out_size != MT * DM || ws_size < WS_END) {
            fprintf(stderr, "kernel_launch: unexpected shapes: n_in %d in0 %d in1 %d out %d ws %zu (need %zu); nothing launched\n", n_in, n_in > 0 ? in_sizes[0] : -1, n_in > 1 ? in_sizes[1] : -1, out_size, ws_size, (size_t)WS_END);
            grid = -1; return; }
        int dev = 0, cus = 0, per_cu = 0;
        if (hipGetDevice(&dev) != hipSuccess || hipDeviceGetAttribute(&cus, hipDeviceAttributeMultiprocessorCount, dev) != hipSuccess) { grid = -1; return; }
        if (hipFuncSetAttribute((const void*)fwd, hipFuncAttributeMaxDynamicSharedMemorySize, LDS_BYTES) != hipSuccess) { fprintf(stderr, "kernel_launch: hipFuncSetAttribute failed\n"); grid = -1; return; }
        if (hipOccupancyMaxActiveBlocksPerMultiprocessor(&per_cu, (const void*)fwd, NTHR, LDS_BYTES) != hipSuccess || per_cu < 1) { fprintf(stderr, "kernel_launch: occupancy query says %d\n", per_cu); per_cu = 1; }
        (void)hipGetLastError();
        grid = cus;
        if (grid > 256) grid = 256;
    }
    if (grid < 0) return;
    Args a{};
    for (int i = 0; i < 17; ++i) a.in[i] = (const float*)d_in[i];
    a.out = (float*)d_out; a.ws = (unsigned char*)d_ws;
#if MK_FUSED
    a.ph_lo = 0; a.ph_hi = N_PHASES;
    void* kargs[] = {&a};
    hipError_t e = hipLaunchCooperativeKernel((const void*)fwd, dim3(grid), dim3(NTHR), kargs, LDS_BYTES, stream);
    if (e != hipSuccess) fprintf(stderr, "kernel_launch: cooperative launch failed: %s (grid %d)\n", hipGetErrorString(e), grid);
#else
    for (int p = 0; p < N_PHASES; ++p) {
        a.ph_lo = p; a.ph_hi = p + 1;
        hipLaunchKernelGGL(fwd, dim3(grid), dim3(NTHR), LDS_BYTES, stream, a);
        const hipError_t le = hipPeekAtLastError();
        if (le != hipSuccess) { fprintf(stderr, "kernel_launch: launch %d failed: %s\n", p, hipGetErrorName(le)); break; }
    }
#endif
}
```

```cpp
#include <hip/hip_runtime.h>
#include <hip/hip_cooperative_groups.h>
#include <cstdio>
#include <cstdint>
namespace cg = cooperative_groups;

#ifndef MK_FUSED
#define MK_FUSED 1
#endif

#define LAS __attribute__((address_space(3)))
typedef unsigned short bf16_t;
typedef short bf16x8 __attribute__((ext_vector_type(8)));
typedef float f32x4 __attribute__((ext_vector_type(4)));
typedef float f32x2 __attribute__((ext_vector_type(2)));
typedef unsigned u32x4 __attribute__((ext_vector_type(4)));
typedef unsigned u32x2 __attribute__((ext_vector_type(2)));

constexpr int DM = 1024;
constexpr int MP = 16 * 2048, MS = 16384, MT = MP + MS;
constexpr int NSEQ = 17, NMEM = 256, MMEM = NSEQ * NMEM;
constexpr int INW = 7168;
constexpr float EPS = 1e-6f;
constexpr int NTHR = 512, NWAVES = 8;

constexpr size_t MiB = 1u << 20;
constexpr size_t WS_W1T = 1 * MiB;
constexpr size_t WS_WGT = 10 * MiB;
constexpr size_t WS_WPOT = 16 * MiB, WS_WFAT = 18 * MiB, WS_WOT = 20 * MiB, WS_WKVT = 22 * MiB;
constexpr size_t WS_MN = 24 * MiB;
constexpr size_t WS_KV = 33 * MiB;
constexpr size_t WS_XN = 48 * MiB;
constexpr size_t WS_PA = 144 * MiB;
constexpr size_t WS_FO = 240 * MiB;
constexpr size_t WS_AB = 336 * MiB;
constexpr size_t WS_Q = 432 * MiB;
constexpr size_t WS_END = 480 * MiB;
constexpr size_t OUT_PVF = 0, OUT_Y1 = 96 * MiB, OUT_STASH = 0;

constexpr int RING_BYTES = 131072;
constexpr int TAB_OFF = RING_BYTES + 1024;
constexpr int LDS_BYTES = 147456;

__device__ __forceinline__ unsigned f2bf(float f) { unsigned u = __builtin_bit_cast(unsigned, f); return (u + 0x7fffu + ((u >> 16) & 1u)) >> 16; }
__device__ __forceinline__ unsigned pk2(float lo, float hi) { return f2bf(lo) | (f2bf(hi) << 16); }
__device__ __forceinline__ float bflo(unsigned u) { return __builtin_bit_cast(float, u << 16); }
__device__ __forceinline__ float bfhi(unsigned u) { return __builtin_bit_cast(float, u & 0xffff0000u); }
__device__ __forceinline__ unsigned cvt_pk_bf16(float lo, float hi) { unsigned r; asm volatile("v_cvt_pk_bf16_f32 %0, %1, %2" : "=v"(r) : "v"(lo), "v"(hi)); return r; }
__device__ __forceinline__ float sigmoid_f(float v) { return __builtin_amdgcn_rcpf(1.0f + __expf(-v)); }
__device__ __forceinline__ float silu_f(float v) { return v * sigmoid_f(v); }
__device__ __forceinline__ float wave_sum(float v) {
#pragma unroll
    for (int o = 1; o < 64; o <<= 1) v += __shfl_xor(v, o);
    return v;
}
__device__ __forceinline__ float wave_max(float v) {
#pragma unroll
    for (int o = 1; o < 64; o <<= 1) v = fmaxf(v, __shfl_xor(v, o));
    return v;
}
#define LDS_WAIT() asm volatile("s_waitcnt lgkmcnt(0)" ::: "memory")

namespace pg8 {
constexpr int BM = 256, BK = 64, HALF = 128, HTB = HALF * BK * 2, STAGE_BYTES = 8 * HTB, NXCD = 8, WGM = 8;
constexpr int KP = 1024;
constexpr size_t TSTEP = (size_t)BM * KP * 2;
__device__ __forceinline__ int lds_byte(int r, int c) { const int st = (r >> 4) * 2 + (c >> 5), rr = r & 15, cc = c & 31, ob = rr * 64 + cc * 2; return st * 1024 + (ob ^ (((ob >> 9) & 1) << 5)); }
__device__ __forceinline__ void stage_rc(int b, int& R, int& C) { const int st = b / 1024, sb = b % 1024, swz = sb ^ (((sb >> 9) & 1) << 5); R = (st >> 1) * 16 + swz / 64; C = (st & 1) * 32 + (swz % 64) / 2; }
__device__ __forceinline__ int perm32(int rho) { const int n = rho >> 4, i = rho & 15; return 8 * (i >> 2) + 4 * n + (i & 3); }

struct Unit { const char* A; const char* B; int nt, pm, pn, seg; };

__device__ __forceinline__ void tile_order(int L, int nM, int nN, int& pm, int& pn) {
    const int nwg = nM * nN; int wgid = L;
    { const int q = nwg / NXCD, r = nwg % NXCD, xcd = wgid % NXCD, off = wgid / NXCD; wgid = (xcd < r ? xcd * (q + 1) : r * (q + 1) + (xcd - r) * q) + off; }
    const int nig = WGM * nN, gid = wgid / nig, fm = gid * WGM, gsz = (nM - fm) < WGM ? (nM - fm) : WGM;
    pm = fm + ((wgid % nig) % gsz); pn = (wgid % nig) / gsz;
}

template <class Epi, class Sched, bool ALIGN_EPI, bool SP2>
__device__ __forceinline__ void gemm_phase(LAS unsigned char* lds, const Sched& S, const Epi& E) {
    const int tid = threadIdx.x, wid = __builtin_amdgcn_readfirstlane(tid >> 6), lane = tid & 63, wr = wid >> 2, wc = wid & 3, fr = lane & 15, fq = lane >> 4;
    unsigned voffA[2], voffB[2];
#pragma unroll
    for (int i = 0; i < 2; ++i) { int R, C; stage_rc(tid * 16 + i * 8192, R, C); const int Rb = Epi::PERM ? ((R & ~31) + perm32(R & 31)) : R;
        voffA[i] = (unsigned)(R * KP + C) * 2u; voffB[i] = (unsigned)(Rb * KP + C) * 2u; }
    const size_t kstep = (size_t)(BK * 2);
    const size_t hstep = (size_t)HALF * KP * 2;
    const unsigned ldsw = (unsigned)wid * 1024u;
    const int aoff = lds_byte(wr * 64 + fr, fq * 8), boff = lds_byte(wc * 32 + fr, fq * 8);
#define PG8_SA(b, h) (((b) * 2 + (h)) * HTB)
#define PG8_SB(b, h) ((4 + (b) * 2 + (h)) * HTB)
#define PG8_STAGE(bufoff, gbase, voff) do { _Pragma("unroll") for (int _i = 0; _i < 2; ++_i) \
        __builtin_amdgcn_global_load_lds((const unsigned*)((const char*)(gbase) + (voff)[_i]), (LAS unsigned*)(lds + (bufoff) + ldsw + _i * 8192), 16, 0, 0); } while (0)
#define PG8_LDA(dst, b, h) do { _Pragma("unroll") for (int m = 0; m < 4; ++m) _Pragma("unroll") for (int k = 0; k < 2; ++k) dst[m][k] = *(const LAS bf16x8*)(lds + PG8_SA(b, h) + aoff + m * 2048 + k * 1024); } while (0)
#define PG8_LDB(dst, b, h) do { _Pragma("unroll") for (int n = 0; n < 2; ++n) _Pragma("unroll") for (int k = 0; k < 2; ++k) dst[n][k] = *(const LAS bf16x8*)(lds + PG8_SB(b, h) + boff + n * 2048 + k * 1024); } while (0)
#define PG8_MMA(ai, bj, At, Bt) do { __builtin_amdgcn_s_setprio(1); _Pragma("unroll") for (int m = 0; m < 4; ++m) _Pragma("unroll") for (int n = 0; n < 2; ++n) _Pragma("unroll") for (int k = 0; k < 2; ++k) \
        acc[ai][bj][m][n] = __builtin_amdgcn_mfma_f32_16x16x32_bf16(Bt[n][k], At[m][k], acc[ai][bj][m][n], 0, 0, 0); __builtin_amdgcn_s_setprio(0); } while (0)
#define PG8_WAIT_V(n) asm volatile("s_waitcnt vmcnt(" #n ")" ::: "memory")
#define PG8_WAIT_L(n) asm volatile("s_waitcnt lgkmcnt(" #n ")" ::: "memory")
#define PG8_BAR __builtin_amdgcn_s_barrier()
#define PG8_SCHED __builtin_amdgcn_sched_barrier(0)
    Unit cur, nxt; int ui = 0;
    if (!S.next(0, cur)) return;
    f32x4 acc[2][2][4][2];
#pragma unroll
    for (int a = 0; a < 2; ++a)
#pragma unroll
        for (int b = 0; b < 2; ++b)
#pragma unroll
            for (int m = 0; m < 4; ++m)
#pragma unroll
                for (int n = 0; n < 2; ++n) acc[a][b][m][n] = (f32x4){0.f, 0.f, 0.f, 0.f};
    bf16x8 At[4][2], B0[2][2], B1[2][2];
    const char* cA = cur.A; const char* cB = cur.B;
    if constexpr (SP2) {
        PG8_STAGE(PG8_SB(0, 0), cB, voffB); PG8_STAGE(PG8_SB(0, 1), cB + hstep, voffB); PG8_STAGE(PG8_SA(0, 0), cA, voffA); PG8_STAGE(PG8_SA(0, 1), cA + hstep, voffA);
        if (wr == 1) PG8_BAR;
        PG8_WAIT_V(2); PG8_BAR;
        PG8_STAGE(PG8_SB(1, 0), cB + kstep, voffB); PG8_STAGE(PG8_SA(1, 0), cA + kstep, voffA); PG8_STAGE(PG8_SB(1, 1), cB + hstep + kstep, voffB);
        PG8_WAIT_V(6); PG8_BAR;
    } else {
        PG8_STAGE(PG8_SB(0, 0), cB, voffB); PG8_STAGE(PG8_SA(0, 0), cA, voffA); PG8_STAGE(PG8_SB(0, 1), cB + hstep, voffB); PG8_STAGE(PG8_SA(0, 1), cA + hstep, voffA);
        if (wr == 1) PG8_BAR;
        PG8_WAIT_V(4); PG8_BAR;
        PG8_STAGE(PG8_SB(1, 0), cB + kstep, voffB); PG8_STAGE(PG8_SA(1, 0), cA + kstep, voffA); PG8_STAGE(PG8_SB(1, 1), cB + hstep + kstep, voffB);
        PG8_WAIT_V(6); PG8_BAR;
    }
    for (;;) {
        const bool has_next = S.next(ui + 1, nxt);
        const char* nA = has_next ? nxt.A : cA; const char* nB = has_next ? nxt.B : cB;
        const int nt = cur.nt;
        for (int t = 0; t < nt; t += 2) {
            const bool last = (t == nt - 2);
            const char* a1 = cA + (size_t)(t + 1) * kstep;
            const char* a2 = last ? nA : cA + (size_t)(t + 2) * kstep; const char* b2 = last ? nB : cB + (size_t)(t + 2) * kstep;
            const char* a3 = a2 + kstep; const char* b3 = b2 + kstep;
            if constexpr (SP2) {
            PG8_LDB(B0, 0, 0); PG8_LDB(B1, 0, 1); PG8_SCHED; PG8_LDA(At, 0, 0); PG8_STAGE(PG8_SA(1, 1), a1 + hstep, voffA);
            PG8_WAIT_V(8); PG8_WAIT_L(0); PG8_BAR; PG8_MMA(0, 0, At, B0); PG8_MMA(0, 1, At, B1); PG8_BAR; PG8_SCHED;
            PG8_LDA(At, 0, 1); PG8_STAGE(PG8_SB(0, 0), b2, voffB); PG8_STAGE(PG8_SB(0, 1), b2 + hstep, voffB); PG8_STAGE(PG8_SA(0, 0), a2, voffA);
            PG8_WAIT_V(8); PG8_WAIT_L(0); PG8_BAR; PG8_MMA(1, 0, At, B0); PG8_MMA(1, 1, At, B1); PG8_BAR; PG8_SCHED;
            PG8_LDB(B0, 1, 0); PG8_LDB(B1, 1, 1); PG8_SCHED; PG8_LDA(At, 1, 0); PG8_STAGE(PG8_SA(0, 1), a2 + hstep, voffA);
            PG8_WAIT_V(8); PG8_WAIT_L(0); PG8_BAR; PG8_MMA(0, 0, At, B0); PG8_MMA(0, 1, At, B1); PG8_BAR; PG8_SCHED;
            PG8_LDA(At, 1, 1); PG8_STAGE(PG8_SB(1, 0), b3, voffB); PG8_STAGE(PG8_SB(1, 1), b3 + hstep, voffB); PG8_STAGE(PG8_SA(1, 0), a3, voffA);
            PG8_WAIT_V(8); PG8_WAIT_L(0); PG8_BAR; PG8_MMA(1, 0, At, B0); PG8_MMA(1, 1, At, B1); PG8_BAR; PG8_SCHED;
            } else {
            PG8_LDB(B0, 0, 0); PG8_SCHED; PG8_LDA(At, 0, 0); PG8_STAGE(PG8_SA(1, 1), a1 + hstep, voffA);
            PG8_WAIT_L(8); PG8_BAR; PG8_WAIT_L(0); PG8_MMA(0, 0, At, B0); PG8_BAR; PG8_SCHED;
            PG8_LDB(B1, 0, 1); PG8_STAGE(PG8_SB(0, 0), b2, voffB);
            PG8_BAR; PG8_WAIT_L(0); PG8_MMA(0, 1, At, B1); PG8_BAR;
            PG8_LDA(At, 0, 1); PG8_STAGE(PG8_SA(0, 0), a2, voffA);
            PG8_BAR; PG8_WAIT_L(0); PG8_MMA(1, 0, At, B0); PG8_BAR; PG8_SCHED;
            PG8_STAGE(PG8_SB(0, 1), b2 + hstep, voffB);
            PG8_WAIT_V(6); PG8_BAR; PG8_MMA(1, 1, At, B1); PG8_BAR;
            PG8_LDB(B0, 1, 0); PG8_SCHED; PG8_LDA(At, 1, 0); PG8_STAGE(PG8_SA(0, 1), a2 + hstep, voffA);
            PG8_WAIT_L(8); PG8_BAR; PG8_WAIT_L(0); PG8_MMA(0, 0, At, B0); PG8_BAR; PG8_SCHED;
            PG8_LDB(B1, 1, 1); PG8_STAGE(PG8_SB(1, 0), b3, voffB);
            PG8_BAR; PG8_WAIT_L(0); PG8_MMA(0, 1, At, B1); PG8_BAR;
            PG8_LDA(At, 1, 1); PG8_STAGE(PG8_SA(1, 0), a3, voffA);
            PG8_BAR; PG8_WAIT_L(0); PG8_MMA(1, 0, At, B0); PG8_BAR; PG8_SCHED;
            PG8_STAGE(PG8_SB(1, 1), b3 + hstep, voffB);
            PG8_WAIT_V(6); PG8_BAR; PG8_MMA(1, 1, At, B1); PG8_BAR;
            }
        }
        if constexpr (ALIGN_EPI) { if (wr == 0) PG8_BAR; }
        E(acc, cur, wr, wc, fr, fq);
        if (!has_next) break;
#pragma unroll
        for (int a = 0; a < 2; ++a)
#pragma unroll
            for (int b = 0; b < 2; ++b)
#pragma unroll
                for (int m = 0; m < 4; ++m)
#pragma unroll
                    for (int n = 0; n < 2; ++n) acc[a][b][m][n] = (f32x4){0.f, 0.f, 0.f, 0.f};
        cur = nxt; cA = nA; cB = nB; ++ui;
        if constexpr (ALIGN_EPI) { if (wr == 1) PG8_BAR; }
    }
    PG8_WAIT_V(0);
    if constexpr (!ALIGN_EPI) { if (wr == 0) PG8_BAR; }
    PG8_BAR;
#undef PG8_SA
#undef PG8_SB
#undef PG8_STAGE
#undef PG8_LDA
#undef PG8_LDB
#undef PG8_MMA
#undef PG8_WAIT_V
#undef PG8_WAIT_L
#undef PG8_BAR
#undef PG8_SCHED
}
}
using pg8::Unit;

struct Ctx {
    LAS unsigned char* lds;
    int tid, lane, wave, G, bid;
    const float *xp, *xs, *memp, *mems, *norm_in, *norm_mem, *w_in, *w_pool_grp, *pool_scale, *w_four_grp, *w_kv, *w_pool_out, *w_four_out, *w_attn_out, *b_gate, *w_o, *norm_f;
    float* out;
    bf16_t *W1T, *WGT, *WPOT, *WFAT, *WOT, *WKVT, *MN, *KV, *XN, *PA, *FO, *AB, *Q, *PVF, *Y1, *MERGED;
    unsigned char* stash;
};

struct SchedP1 {
    int G, c; const char *XN, *W1T, *MN, *WKVT;
    __device__ __forceinline__ bool next(int i, Unit& u) const {
        int L = i * G + c; u.nt = 16;
        if (L < 192 * 18) { pg8::tile_order(L, 192, 18, u.pm, u.pn); u.A = XN + (size_t)u.pm * pg8::TSTEP; u.B = W1T + (size_t)u.pn * pg8::TSTEP; u.seg = 0; return true; }
        L -= 192 * 18; if (L >= 17 * 4) return false;
        u.pm = L % 17; u.pn = L / 17; u.A = MN + (size_t)u.pm * pg8::TSTEP; u.B = WKVT + (size_t)u.pn * pg8::TSTEP; u.seg = 1; return true;
    }
};
struct EpiP1 {
    static constexpr bool PERM = true;
    bf16_t *PVF, *SPG, *AB, *FO, *Q, *KV;
    __device__ __forceinline__ void operator()(const f32x4 (&acc)[2][2][4][2], const Unit& u, int wr, int wc, int fr, int fq) const {
        bf16_t* base; int ld, colt, act; const int pn = u.pn;
        if (u.seg == 1) { base = KV; ld = 1024; colt = pn * 256; act = 0; }
        else if (pn < 4) { base = PVF; ld = 1024; colt = pn * 256; act = 0; }
        else if (pn < 8) { base = SPG; ld = 1024; colt = (pn - 4) * 256; act = 1; }
        else if (pn < 12) { base = AB; ld = 1024; colt = (pn - 8) * 256; act = 0; }
        else if (pn < 14) { base = FO; ld = 1024; colt = (pn - 12) * 256; act = 1; }
        else if (pn < 16) { base = Q; ld = 512; colt = (pn - 14) * 256; act = 0; }
        else { base = FO; ld = 1024; colt = 512 + (pn - 16) * 256; act = 1; }
        const int row0 = u.pm * 256 + wr * 64 + fr, col0 = colt + wc * 32 + 8 * fq;
#pragma unroll
        for (int ai = 0; ai < 2; ++ai)
#pragma unroll
            for (int m = 0; m < 4; ++m) { bf16_t* rowp = base + (size_t)(row0 + ai * 128 + m * 16) * ld + col0;
#pragma unroll
                for (int bj = 0; bj < 2; ++bj) { f32x4 v0 = acc[ai][bj][m][0], v1 = acc[ai][bj][m][1];
                    if (act) {
#pragma unroll
                        for (int j = 0; j < 4; ++j) { v0[j] = silu_f(v0[j]); v1[j] = silu_f(v1[j]); } }
                    u32x4 w; w.x = cvt_pk_bf16(v0[0], v0[1]); w.y = cvt_pk_bf16(v0[2], v0[3]); w.z = cvt_pk_bf16(v1[0], v1[1]); w.w = cvt_pk_bf16(v1[2], v1[3]);
                    *(u32x4*)(rowp + bj * 128) = w; } }
    }
};
struct SchedP3 {
    int G, c; const char *PA, *XN, *FO, *WPOT, *WGT, *WFAT;
    __device__ __forceinline__ bool next(int i, Unit& u) const {
        const int ti = i / 6, seg = i - 6 * ti, L = ti * G + c; if (L >= 192 * 4) return false;
        pg8::tile_order(L, 192, 4, u.pm, u.pn); u.seg = seg;
        const size_t am = (size_t)u.pm * pg8::TSTEP, bn = (size_t)u.pn * pg8::TSTEP;
        if (seg == 0) { u.A = PA + am; u.B = WPOT + bn; u.nt = 16; }
        else if (seg == 2) { u.A = FO + am; u.B = WFAT + bn; u.nt = 8; }
        else if (seg == 4) { u.A = FO + am + 1024; u.B = WFAT + bn + 1024; u.nt = 8; }
        else { u.A = XN + am; u.B = WGT + (size_t)(4 * (seg >> 1) + u.pn) * pg8::TSTEP; u.nt = 16; }
        return true;
    }
};
struct EpiP3 {
    static constexpr bool PERM = true;
    unsigned char* stash; const float* bgate; bf16_t* MERGED;
    __device__ __forceinline__ void operator()(const f32x4 (&acc)[2][2][4][2], const Unit& u, int wr, int wc, int fr, int fq) const {
        const int tid = threadIdx.x, seg = u.seg;
        const unsigned toff = (unsigned)tid * 16u; const __amdgpu_buffer_rsrc_t srs = __builtin_amdgcn_make_buffer_rsrc((void*)stash, (short)0, 262144, 0x00020000);
        if ((seg & 1) == 0) {
#pragma unroll
            for (int ai = 0; ai < 2; ++ai)
#pragma unroll
                for (int bj = 0; bj < 2; ++bj)
#pragma unroll
                    for (int m = 0; m < 4; ++m) { const f32x4 v0 = acc[ai][bj][m][0], v1 = acc[ai][bj][m][1];
                        u32x4 w; w.x = cvt_pk_bf16(v0[0], v0[1]); w.y = cvt_pk_bf16(v0[2], v0[3]); w.z = cvt_pk_bf16(v1[0], v1[1]); w.w = cvt_pk_bf16(v1[2], v1[3]);
                        __builtin_amdgcn_raw_buffer_store_b128(w, srs, toff, ((ai * 2 + bj) * 4 + m) * 8192, 0); }
        } else {
            const int bcol0 = (seg >> 1) * 1024 + u.pn * 256 + wc * 32 + 8 * fq;
            const int row0 = u.pm * 256 + wr * 64 + fr, col0 = u.pn * 256 + wc * 32 + 8 * fq;
#pragma unroll
            for (int bj = 0; bj < 2; ++bj) {
                const f32x4 b0 = *(const f32x4*)(bgate + bcol0 + bj * 128), b1 = *(const f32x4*)(bgate + bcol0 + bj * 128 + 4);
#pragma unroll
                for (int ai = 0; ai < 2; ++ai)
#pragma unroll
                    for (int m = 0; m < 4; ++m) { const int j = (ai * 2 + bj) * 4 + m;
                        const u32x4 yv = __builtin_amdgcn_raw_buffer_load_b128(srs, toff, j * 8192, 0);
                        const f32x4 a0 = acc[ai][bj][m][0] + b0, a1 = acc[ai][bj][m][1] + b1;
                        float r[8];
                        r[0] = sigmoid_f(a0[0]) * bflo(yv.x); r[1] = sigmoid_f(a0[1]) * bfhi(yv.x); r[2] = sigmoid_f(a0[2]) * bflo(yv.y); r[3] = sigmoid_f(a0[3]) * bfhi(yv.y);
                        r[4] = sigmoid_f(a1[0]) * bflo(yv.z); r[5] = sigmoid_f(a1[1]) * bfhi(yv.z); r[6] = sigmoid_f(a1[2]) * bflo(yv.w); r[7] = sigmoid_f(a1[3]) * bfhi(yv.w);
                        if (seg >= 3) { const u32x4 mv = __builtin_amdgcn_raw_buffer_load_b128(srs, toff, 131072 + j * 8192, 0);
                            r[0] += bflo(mv.x); r[1] += bfhi(mv.x); r[2] += bflo(mv.y); r[3] += bfhi(mv.y); r[4] += bflo(mv.z); r[5] += bfhi(mv.z); r[6] += bflo(mv.w); r[7] += bfhi(mv.w); }
                        u32x4 w; w.x = cvt_pk_bf16(r[0], r[1]); w.y = cvt_pk_bf16(r[2], r[3]); w.z = cvt_pk_bf16(r[4], r[5]); w.w = cvt_pk_bf16(r[6], r[7]);
                        if (seg < 5) __builtin_amdgcn_raw_buffer_store_b128(w, srs, toff, 131072 + j * 8192, 0);
                        else *(u32x4*)(MERGED + (size_t)(row0 + ai * 128 + m * 16) * 1024 + col0 + bj * 128) = w;
                        if (m & 1) asm volatile("" ::: "memory"); }
            }
        }
    }
};
struct SchedP4 {
    int G, c; const char *MERGED, *WOT;
    __device__ __forceinline__ bool next(int i, Unit& u) const {
        const int L = i * G + c; if (L >= 192 * 4) return false;
        pg8::tile_order(L, 192, 4, u.pm, u.pn); u.A = MERGED + (size_t)u.pm * pg8::TSTEP; u.B = WOT + (size_t)u.pn * pg8::TSTEP; u.nt = 16; u.seg = 0; return true;
    }
};
struct EpiP4 {
    static constexpr bool PERM = false;
    const float *xp, *xs; float* out;
    __device__ __forceinline__ void operator()(const f32x4 (&acc)[2][2][4][2], const Unit& u, int wr, int wc, int fr, int fq) const {
        const int row0 = u.pm * 256 + wr * 64 + fr, col0 = u.pn * 256 + wc * 32 + 4 * fq;
        const float* xb = (u.pm < MP / 256) ? xp : xs - (size_t)MP * DM;
#pragma unroll
        for (int ai = 0; ai < 2; ++ai)
#pragma unroll
            for (int m = 0; m < 4; ++m) { const size_t off = (size_t)(row0 + ai * 128 + m * 16) * DM + col0;
#pragma unroll
                for (int bj = 0; bj < 2; ++bj)
#pragma unroll
                    for (int n = 0; n < 2; ++n) { const f32x4 xv = *(const f32x4*)(xb + off + bj * 128 + n * 16); *(f32x4*)(out + off + bj * 128 + n * 16) = xv + acc[ai][bj][m][n]; }
                asm volatile("" ::: "memory"); }
    }
};

__device__ __forceinline__ void transpose_item(const float* W, int ldw, bf16_t* WT, int nblk, LAS float* scr, int item, int lane) {
    const int kb = item / nblk, nb = item % nblk, k0 = 64 * kb, n0 = 32 * nb;
#pragma unroll 8
    for (int i = 0; i < 32; ++i) { const int kk = 2 * i + (lane >> 5); scr[kk * 33 + (lane & 31)] = W[(size_t)(k0 + kk) * ldw + n0 + (lane & 31)]; }
    LDS_WAIT(); asm volatile("" ::: "memory");
    const int c = lane & 7;
#pragma unroll
    for (int j = 0; j < 4; ++j) { const int n = (lane >> 3) + 8 * j; const LAS float* s = scr + (8 * c) * 33 + n;
        u32x4 o; o.x = pk2(s[0 * 33], s[1 * 33]); o.y = pk2(s[2 * 33], s[3 * 33]); o.z = pk2(s[4 * 33], s[5 * 33]); o.w = pk2(s[6 * 33], s[7 * 33]);
        *(u32x4*)(WT + (size_t)(n0 + n) * 1024 + k0 + 8 * c) = o; }
    LDS_WAIT(); asm volatile("" ::: "memory");
}
__device__ __forceinline__ void rms_row_to_bf16(const float* xrow, const float* gain, bf16_t* orow, int lane) {
    const f32x4* xr = (const f32x4*)xrow + lane; const f32x4* gr = (const f32x4*)gain + lane;
    f32x4 v[4]; float s = 0.f;
#pragma unroll
    for (int j = 0; j < 4; ++j) { v[j] = xr[64 * j]; s += (v[j].x * v[j].x + v[j].y * v[j].y) + (v[j].z * v[j].z + v[j].w * v[j].w); }
    const float r = 1.0f / sqrtf(wave_sum(s) * (1.f / DM) + EPS);
    u32x2* o8 = (u32x2*)orow + lane;
#pragma unroll
    for (int j = 0; j < 4; ++j) { const f32x4 g = gr[64 * j]; u32x2 w; w.x = pk2(v[j].x * r * g.x, v[j].y * r * g.y); w.y = pk2(v[j].z * r * g.z, v[j].w * r * g.w); o8[64 * j] = w; }
}
__device__ __forceinline__ void fold_item(const Ctx& F, int item) {
    LAS float* As = (LAS float*)F.lds;
    LAS float* Bs = (LAS float*)(F.lds + 16384);
    LAS float* Ts = (LAS float*)(F.lds + 32768);
    const LAS f32x2* tab = (const LAS f32x2*)(F.lds + TAB_OFF);
    const int tid = F.tid, tk = tid & 63, tj = tid >> 6;
    float acc[8];
#pragma unroll
    for (int j = 0; j < 8; ++j) acc[j] = 0.f;
    if (item < 256) {
        const int g = item >> 6, k0 = ((item >> 2) & 15) * 64, j0 = (item & 3) * 64;
        for (int c0 = 0; c0 < 256; c0 += 32) {
            __syncthreads();
#pragma unroll
            for (int i = 0; i < 4; ++i) { const int idx = tid + 512 * i; { const int kk = idx >> 5, cc = idx & 31; As[kk * 33 + cc] = F.w_in[(size_t)(k0 + kk) * INW + g * 256 + c0 + cc]; }
                { const int cc = idx >> 6, jj = idx & 63; Bs[cc * 64 + jj] = F.w_pool_grp[(size_t)(g * 256 + c0 + cc) * 256 + j0 + jj]; } }
            __syncthreads();
#pragma unroll 8
            for (int cc = 0; cc < 32; ++cc) { const float a = As[tk * 33 + cc];
#pragma unroll
                for (int j = 0; j < 8; ++j) acc[j] += a * Bs[cc * 64 + tj * 8 + j]; }
        }
#pragma unroll
        for (int j = 0; j < 8; ++j) { const int n = g * 256 + j0 + tj * 8 + j; F.W1T[(size_t)n * 1024 + k0 + tk] = (bf16_t)f2bf(acc[j] * F.pool_scale[n]); }
    } else {
        const int it = item - 256, g = it >> 6, sn = (it >> 5) & 1, k0 = ((it >> 1) & 15) * 64, j0 = (it & 1) * 64;
        __syncthreads();
        { const int c = tid & 127, jq = tid >> 7; float t[16];
#pragma unroll
            for (int j = 0; j < 16; ++j) t[j] = 0.f;
            for (int d = 0; d < 128; ++d) { const f32x2 cs = tab[(c * d) & 127]; const float w = sn ? cs.y : cs.x;
                const f32x4* wp = (const f32x4*)(F.w_four_grp + (size_t)(g * 128 + d) * 128 + j0 + jq * 16);
#pragma unroll
                for (int q = 0; q < 4; ++q) { const f32x4 x = wp[q]; t[4 * q] += w * x.x; t[4 * q + 1] += w * x.y; t[4 * q + 2] += w * x.z; t[4 * q + 3] += w * x.w; } }
#pragma unroll
            for (int j = 0; j < 16; ++j) Ts[c * 64 + jq * 16 + j] = t[j] * 0.08838834764831845f; }
        for (int c0 = 0; c0 < 128; c0 += 32) {
            __syncthreads();
#pragma unroll
            for (int i = 0; i < 4; ++i) { const int idx = tid + 512 * i; const int kk = idx >> 5, cc = idx & 31; As[kk * 33 + cc] = F.w_in[(size_t)(k0 + kk) * INW + 2048 + g * 128 + c0 + cc]; }
            __syncthreads();
#pragma unroll 8
            for (int cc = 0; cc < 32; ++cc) { const float a = As[tk * 33 + cc];
#pragma unroll
                for (int j = 0; j < 8; ++j) acc[j] += a * Ts[(c0 + cc) * 64 + tj * 8 + j]; }
        }
#pragma unroll
        for (int j = 0; j < 8; ++j) { const int n = 2048 + sn * 512 + g * 128 + j0 + tj * 8 + j; F.W1T[(size_t)n * 1024 + k0 + tk] = (bf16_t)f2bf(acc[j]); }
    }
    __syncthreads();
}
__device__ __forceinline__ void p0_prologue(const Ctx& F) {
    for (int it = F.bid; it < 512; it += F.G) fold_item(F, it);
    __syncthreads();
    LAS float* scr = (LAS float*)(F.lds + F.wave * 16384);
    const int gw = F.bid * NWAVES + F.wave, NGW = F.G * NWAVES;
    constexpr int I0 = 16 * 32, I1 = 16 * 16, I4 = 16 * 96, I5 = 16 * 32, I6 = 8 * 32;
    constexpr int NITEMS = I0 + 3 * I1 + I4 + I5 + 2 * I6 + 2 * I5;
    for (int it = gw; it < NITEMS; it += NGW) {
        int r = it;
        if (r < I0) { transpose_item(F.w_in + 1024, INW, F.W1T + (size_t)1024 * 1024, 32, scr, r, F.lane); continue; } r -= I0;
        if (r < I1) { transpose_item(F.w_in + 2560, INW, F.W1T + (size_t)3072 * 1024, 16, scr, r, F.lane); continue; } r -= I1;
        if (r < I1) { transpose_item(F.w_in + 3072, INW, F.W1T + (size_t)3584 * 1024, 16, scr, r, F.lane); continue; } r -= I1;
        if (r < I1) { transpose_item(F.w_in + 3584, INW, F.W1T + (size_t)4096 * 1024, 16, scr, r, F.lane); continue; } r -= I1;
        if (r < I4) { transpose_item(F.w_in + 4096, INW, F.WGT, 96, scr, r, F.lane); continue; } r -= I4;
        if (r < I5) { transpose_item(F.w_pool_out, 1024, F.WPOT, 32, scr, r, F.lane); continue; } r -= I5;
        if (r < I6) { transpose_item(F.w_four_out, 1024, F.WFAT, 32, scr, r, F.lane); continue; } r -= I6;
        if (r < I6) { transpose_item(F.w_attn_out, 1024, F.WFAT + 512, 32, scr, r, F.lane); continue; } r -= I6;
        if (r < I5) { transpose_item(F.w_o, 1024, F.WOT, 32, scr, r, F.lane); continue; } r -= I5;
        transpose_item(F.w_kv, 1024, F.WKVT, 32, scr, r, F.lane);
    }
    for (int m = gw; m < MT + MMEM; m += NGW) {
        if (m < MP) rms_row_to_bf16(F.xp + (size_t)m * DM, F.norm_in, F.XN + (size_t)m * DM, F.lane);
        else if (m < MT) rms_row_to_bf16(F.xs + (size_t)(m - MP) * DM, F.norm_in, F.XN + (size_t)m * DM, F.lane);
        else { const int r = m - MT; const float* src = r < 16 * NMEM ? F.memp + (size_t)r * DM : F.mems + (size_t)(r - 16 * NMEM) * DM; rms_row_to_bf16(src, F.norm_mem, F.MN + (size_t)r * DM, F.lane); }
    }
}

__device__ __forceinline__ void seq_of_row(int row, int& r0, int& S) { if (row < MP) { r0 = row & ~2047; S = 2048; } else { r0 = MP; S = MS; } }
__device__ __forceinline__ void pool_phase(const Ctx& F) {
    const long total = (long)MT * 128;
    for (long it = (long)F.bid * NTHR + F.tid; it < total; it += (long)F.G * NTHR) {
        const int row = (int)(it >> 7), ch = (int)(it & 127), col = ch * 8, g = ch >> 5, half = 1 << g;
        int r0, S; seq_of_row(row, r0, S);
        const int t = row - r0, lo = t - half < 0 ? 0 : t - half, hi = t + half > S ? S : t + half;
        float s[8];
#pragma unroll
        for (int j = 0; j < 8; ++j) s[j] = 0.f;
        for (int i = lo; i < hi; ++i) { const u32x4 v = *(const u32x4*)(F.PVF + (size_t)(r0 + i) * 1024 + col);
            s[0] += bflo(v.x); s[1] += bfhi(v.x); s[2] += bflo(v.y); s[3] += bfhi(v.y); s[4] += bflo(v.z); s[5] += bfhi(v.z); s[6] += bflo(v.w); s[7] += bfhi(v.w); }
        const float inv = 1.0f / (float)(hi - lo);
        const u32x4 me = *(const u32x4*)(F.PVF + (size_t)row * 1024 + col); const u32x4 gt = *(const u32x4*)(F.PA + (size_t)row * 1024 + col);
        u32x4 o;
        o.x = pk2((s[0] * inv - bflo(me.x)) * bflo(gt.x), (s[1] * inv - bfhi(me.x)) * bfhi(gt.x));
        o.y = pk2((s[2] * inv - bflo(me.y)) * bflo(gt.y), (s[3] * inv - bfhi(me.y)) * bfhi(gt.y));
        o.z = pk2((s[4] * inv - bflo(me.z)) * bflo(gt.z), (s[5] * inv - bfhi(me.z)) * bfhi(gt.z));
        o.w = pk2((s[6] * inv - bflo(me.w)) * bflo(gt.w), (s[7] * inv - bfhi(me.w)) * bfhi(gt.w));
        *(u32x4*)(F.PA + (size_t)row * 1024 + col) = o;
    }
}
__device__ __forceinline__ void dft1_phase(const Ctx& F) {
    const LAS f32x2* tab = (const LAS f32x2*)(F.lds + TAB_OFF);
    for (int it = F.bid; it < 16384 + 8192; it += F.G) {
        int seq, s2, head, chk, N1, r0, S, sh;
        if (it < 16384) { seq = it >> 10; const int r = it & 1023; s2 = r >> 3; head = (r >> 1) & 3; chk = r & 1; N1 = 16; r0 = seq * 2048; S = 2048; sh = 3; }
        else { const int r = it - 16384; seq = 16; s2 = r >> 6; head = (r >> 4) & 3; chk = r & 15; N1 = 128; r0 = MP; S = MS; sh = 0; }
        const int k1 = chk * 8 + (F.tid >> 6), col = head * 128 + 2 * (F.tid & 63);
        float yr0 = 0.f, yr1 = 0.f, yi0 = 0.f, yi1 = 0.f;
        for (int s1 = 0; s1 < N1; ++s1) {
            const size_t ro = (size_t)(r0 + 128 * s1 + s2) * 1024 + col;
            const unsigned av = *(const unsigned*)(F.AB + ro), bv = *(const unsigned*)(F.AB + ro + 512);
            const f32x2 cs = tab[((k1 * s1) << sh) & 127];
            const float a0 = bflo(av), a1 = bfhi(av), b0 = bflo(bv), b1 = bfhi(bv);
            yr0 += cs.x * a0 - cs.y * b0; yi0 += cs.y * a0 + cs.x * b0;
            yr1 += cs.x * a1 - cs.y * b1; yi1 += cs.y * a1 + cs.x * b1;
        }
        float tc, ts; { const float ang = 2.0f * (float)(k1 * s2) / (float)S; ts = sinpif(ang); tc = cospif(ang); }
        const float sc = N1 == 16 ? 0.25f : 0.08838834764831845f; tc *= sc; ts *= sc;
        const size_t wo = (size_t)(r0 + 128 * k1 + s2) * 1024 + col;
        *(unsigned*)(F.Y1 + wo) = pk2(yr0 * tc - yi0 * ts, yr1 * tc - yi1 * ts);
        *(unsigned*)(F.Y1 + wo + 512) = pk2(yr0 * ts + yi0 * tc, yr1 * ts + yi1 * tc);
    }
}
__device__ __forceinline__ void dft2_phase(const Ctx& F) {
    const LAS f32x2* tab = (const LAS f32x2*)(F.lds + TAB_OFF);
    for (int it = F.bid; it < 16384 + 8192; it += F.G) {
        int seq, k1, head, chk, N1, r0;
        if (it < 16384) { seq = it >> 10; const int r = it & 1023; k1 = r >> 6; head = (r >> 4) & 3; chk = r & 15; N1 = 16; r0 = seq * 2048; }
        else { const int r = it - 16384; seq = 16; k1 = r >> 6; head = (r >> 4) & 3; chk = r & 15; N1 = 128; r0 = MP; }
        const int k2 = chk * 8 + (F.tid >> 6), col = head * 128 + 2 * (F.tid & 63);
        float f0 = 0.f, f1 = 0.f;
        for (int s2 = 0; s2 < 128; ++s2) {
            const size_t ro = (size_t)(r0 + 128 * k1 + s2) * 1024 + col;
            const unsigned rv = *(const unsigned*)(F.Y1 + ro), iv = *(const unsigned*)(F.Y1 + ro + 512);
            const f32x2 cs = tab[(k2 * s2) & 127];
            f0 += cs.x * bflo(rv) - cs.y * bflo(iv); f1 += cs.x * bfhi(rv) - cs.y * bfhi(iv);
        }
        const size_t wo = (size_t)(r0 + k1 + N1 * k2) * 1024 + col;
        const unsigned gt = *(const unsigned*)(F.FO + wo);
        *(unsigned*)(F.FO + wo) = pk2(f0 * 0.08838834764831845f * bflo(gt), f1 * 0.08838834764831845f * bfhi(gt));
    }
}
__device__ __forceinline__ void attn_phase_simple(const Ctx& F) {
    const int gw = F.bid * NWAVES + F.wave, NGW = F.G * NWAVES, lane = F.lane;
    for (int it = gw; it < MT * 4; it += NGW) {
        const int row = it >> 2, h = it & 3, seq = row < MP ? row >> 11 : 16;
        const bf16_t* q = F.Q + (size_t)row * 512 + h * 128;
        const bf16_t* Kb = F.KV + (size_t)(seq * NMEM) * 1024 + h * 128;
        const bf16_t* Vb = Kb + 512;
        float s[4] = {0.f, 0.f, 0.f, 0.f};
        for (int d = 0; d < 128; d += 8) {
            const u32x4 qv = *(const u32x4*)(q + d);
            const float q0 = bflo(qv.x), q1 = bfhi(qv.x), q2 = bflo(qv.y), q3 = bfhi(qv.y), q4 = bflo(qv.z), q5 = bfhi(qv.z), q6 = bflo(qv.w), q7 = bfhi(qv.w);
#pragma unroll
            for (int i = 0; i < 4; ++i) { const u32x4 kv = *(const u32x4*)(Kb + (size_t)(lane + 64 * i) * 1024 + d);
                s[i] += q0 * bflo(kv.x) + q1 * bfhi(kv.x) + q2 * bflo(kv.y) + q3 * bfhi(kv.y) + q4 * bflo(kv.z) + q5 * bfhi(kv.z) + q6 * bflo(kv.w) + q7 * bfhi(kv.w); }
        }
        const float scale = 0.08838834764831845f;
#pragma unroll
        for (int i = 0; i < 4; ++i) s[i] *= scale;
        const float mx = wave_max(fmaxf(fmaxf(s[0], s[1]), fmaxf(s[2], s[3])));
        float p[4], l = 0.f;
#pragma unroll
        for (int i = 0; i < 4; ++i) { p[i] = __expf(s[i] - mx); l += p[i]; }
        l = wave_sum(l);
        float o0 = 0.f, o1 = 0.f;
#pragma unroll
        for (int i = 0; i < 4; ++i)
            for (int kk = 0; kk < 64; ++kk) { const float pk = __shfl(p[i], kk); const unsigned vv = *(const unsigned*)(Vb + (size_t)(64 * i + kk) * 1024 + 2 * lane); o0 += pk * bflo(vv); o1 += pk * bfhi(vv); }
        const float rl = 1.0f / l;
        unsigned* dst = (unsigned*)(F.FO + (size_t)row * 1024 + 512 + h * 128 + 2 * lane);
        const unsigned gt = *dst;
        *dst = pk2(o0 * rl * bflo(gt), o1 * rl * bfhi(gt));
    }
}
__device__ __forceinline__ void final_norm_phase(const Ctx& F) {
    const int gw = F.bid * NWAVES + F.wave, NGW = F.G * NWAVES;
    for (int m = gw; m < MT; m += NGW) {
        f32x4* xr = (f32x4*)(F.out + (size_t)m * DM) + F.lane; const f32x4* gr = (const f32x4*)F.norm_f + F.lane;
        f32x4 v[4]; float s = 0.f;
#pragma unroll
        for (int j = 0; j < 4; ++j) { v[j] = xr[64 * j]; s += (v[j].x * v[j].x + v[j].y * v[j].y) + (v[j].z * v[j].z + v[j].w * v[j].w); }
        const float r = 1.0f / sqrtf(wave_sum(s) * (1.f / DM) + EPS);
#pragma unroll
        for (int j = 0; j < 4; ++j) { const f32x4 g = gr[64 * j]; xr[64 * j] = v[j] * r * g; }
    }
}

struct Args { const float* in[17]; float* out; unsigned char* ws; int ph_lo, ph_hi; };
constexpr int N_PHASES = 7;
__global__ void __launch_bounds__(NTHR, 2) fwd(Args args) {
    extern __shared__ __attribute__((aligned(16))) unsigned char lds_[];
    cg::grid_group grid = cg::this_grid();
    Ctx F;
    F.lds = (LAS unsigned char*)lds_;
    F.tid = threadIdx.x; F.lane = F.tid & 63; F.wave = __builtin_amdgcn_readfirstlane(F.tid >> 6); F.G = gridDim.x; F.bid = blockIdx.x;
    F.xp = args.in[0]; F.xs = args.in[1]; F.memp = args.in[2]; F.mems = args.in[3]; F.norm_in = args.in[4]; F.norm_mem = args.in[5]; F.w_in = args.in[6]; F.w_pool_grp = args.in[7];
    F.pool_scale = args.in[8]; F.w_four_grp = args.in[9]; F.w_kv = args.in[10]; F.w_pool_out = args.in[11]; F.w_four_out = args.in[12]; F.w_attn_out = args.in[13]; F.b_gate = args.in[14];
    F.w_o = args.in[15]; F.norm_f = args.in[16]; F.out = args.out;
    unsigned char* ws = args.ws; unsigned char* ob = (unsigned char*)args.out;
    F.W1T = (bf16_t*)(ws + WS_W1T); F.WGT = (bf16_t*)(ws + WS_WGT); F.WPOT = (bf16_t*)(ws + WS_WPOT); F.WFAT = (bf16_t*)(ws + WS_WFAT); F.WOT = (bf16_t*)(ws + WS_WOT); F.WKVT = (bf16_t*)(ws + WS_WKVT);
    F.MN = (bf16_t*)(ws + WS_MN); F.KV = (bf16_t*)(ws + WS_KV); F.XN = (bf16_t*)(ws + WS_XN); F.PA = (bf16_t*)(ws + WS_PA); F.FO = (bf16_t*)(ws + WS_FO); F.AB = (bf16_t*)(ws + WS_AB);
    F.Q = (bf16_t*)(ws + WS_Q); F.PVF = (bf16_t*)(ob + OUT_PVF); F.Y1 = (bf16_t*)(ob + OUT_Y1); F.MERGED = (bf16_t*)(ws + WS_AB);
    F.stash = ob + OUT_STASH + (size_t)blockIdx.x * 262144;
    if (F.tid < 128) { LAS f32x2* tab = (LAS f32x2*)(F.lds + TAB_OFF); f32x2 v; v.x = cospif((float)F.tid * (1.0f / 64.0f)); v.y = sinpif((float)F.tid * (1.0f / 64.0f)); tab[F.tid] = v; }
    __syncthreads();
    const int lo = args.ph_lo, hi = args.ph_hi;
#define IN(k) (lo <= (k) && (k) < hi)
#define SEAM(k) do { if (IN(k) && IN((k) + 1)) grid.sync(); } while (0)
    if (IN(0)) { p0_prologue(F); }
    SEAM(0);
    if (IN(1)) {
        SchedP1 S{F.G, F.bid, (const char*)F.XN, (const char*)F.W1T, (const char*)F.MN, (const char*)F.WKVT};
        EpiP1 E{F.PVF, F.PA, F.AB, F.FO, F.Q, F.KV};
        pg8::gemm_phase<EpiP1, SchedP1, true, true>(F.lds, S, E);
    }
    SEAM(1);
    if (IN(2)) { pool_phase(F); dft1_phase(F); attn_phase_simple(F); }
    SEAM(2);
    if (IN(3)) { dft2_phase(F); }
    SEAM(3);
    if (IN(4)) {
        SchedP3 S{F.G, F.bid, (const char*)F.PA, (const char*)F.XN, (const char*)F.FO, (const char*)F.WPOT, (const char*)F.WGT, (const char*)F.WFAT};
        EpiP3 E{F.stash, F.b_gate, F.MERGED};
        pg8::gemm_phase<EpiP3, SchedP3, true, true>(F.lds, S, E);
    }
    SEAM(4);
    if (IN(5)) {
        SchedP4 S{F.G, F.bid, (const char*)F.MERGED, (const char*)F.WOT};
        EpiP4 E{F.xp, F.xs, F.out};
        pg8::gemm_phase<EpiP4, SchedP4, true, true>(F.lds, S, E);
    }
    SEAM(5);
    if (IN(6)) { final_norm_phase(F); }
#undef IN
#undef SEAM
}

extern "C" void kernel_launch(void* const* d_in, const int* in_sizes, int n_in, void* d_out, int out_size, void* d_ws, size_t ws_size, hipStream_t stream) {
    static int grid = 0;
    if (grid == 0) {
        if (n_in != 17 || in_sizes[0] != MP * DM || in_sizes[1] != MS * DM || out_size != MT * DM || ws_size < WS_END) {
            fprintf(stderr, "kernel_launch: unexpected shapes: n_in %d in0 %d in1 %d out %d ws %zu (need %zu); nothing launched\n", n_in, n_in > 0 ? in_sizes[0] : -1, n_in > 1 ? in_sizes[1] : -1, out_size, ws_size, (size_t)WS_END);
            grid = -1; return; }
        int dev = 0, cus = 0, per_cu = 0;
        if (hipGetDevice(&dev) != hipSuccess || hipDeviceGetAttribute(&cus, hipDeviceAttributeMultiprocessorCount, dev) != hipSuccess) { grid = -1; return; }
        if (hipFuncSetAttribute((const void*)fwd, hipFuncAttributeMaxDynamicSharedMemorySize, LDS_BYTES) != hipSuccess) { fprintf(stderr, "kernel_launch: hipFuncSetAttribute failed\n"); grid = -1; return; }
        if (hipOccupancyMaxActiveBlocksPerMultiprocessor(&per_cu, (const void*)fwd, NTHR, LDS_BYTES) != hipSuccess || per_cu < 1) { fprintf(stderr, "kernel_launch: occupancy query says %d\n", per_cu); per_cu = 1; }
        (void)hipGetLastError();
        grid = cus;
        if (grid > 256) grid = 256;
    }
    if (grid < 0) return;
    Args a{};
    for (int i = 0; i < 17; ++i) a.in[i] = (const float*)d_in[i];
    a.out = (float*)d_out; a.ws = (unsigned char*)d_ws;
#if MK_FUSED
    a.ph_lo = 0; a.ph_hi = N_PHASES;
    void* kargs[] = {&a};
    hipError_t e = hipLaunchCooperativeKernel((const void*)fwd, dim3(grid), dim3(NTHR), kargs, LDS_BYTES, stream);
    if (e != hipSuccess) fprintf(stderr, "kernel_launch: cooperative launch failed: %s (grid %d)\n", hipGetErrorString(e), grid);
#else
    for (int p = 0; p < N_PHASES; ++p) {
        a.ph_lo = p; a.ph_hi = p + 1;
        hipLaunchKernelGGL(fwd, dim3(grid), dim3(NTHR), LDS_BYTES, stream, a);
        const hipError_t le = hipPeekAtLastError();
        if (le != hipSuccess) { fprintf(stderr, "kernel_launch: launch %d failed: %s\n", p, hipGetErrorName(le)); break; }
    }
#endif
}
```

```cpp
#include <hip/hip_runtime.h>
#include <hip/hip_cooperative_groups.h>
#include <cstdio>
#include <cstdint>
namespace cg = cooperative_groups;

#ifndef MK_FUSED
#define MK_FUSED 1
#endif

#define LAS __attribute__((address_space(3)))
typedef unsigned short bf16_t;
typedef short bf16x8 __attribute__((ext_vector_type(8)));
typedef float f32x4 __attribute__((ext_vector_type(4)));
typedef float f32x2 __attribute__((ext_vector_type(2)));
typedef unsigned u32x4 __attribute__((ext_vector_type(4)));
typedef unsigned u32x2 __attribute__((ext_vector_type(2)));

constexpr int DM = 1024;
constexpr int MP = 16 * 2048, MS = 16384, MT = MP + MS;
constexpr int NSEQ = 17, NMEM = 256, MMEM = NSEQ * NMEM;
constexpr int INW = 7168;
constexpr float EPS = 1e-6f;
constexpr int NTHR = 512, NWAVES = 8;

constexpr size_t MiB = 1u << 20;
constexpr size_t WS_W1T = 1 * MiB;
constexpr size_t WS_WGT = 10 * MiB;
constexpr size_t WS_WPOT = 16 * MiB, WS_WFAT = 18 * MiB, WS_WOT = 20 * MiB, WS_WKVT = 22 * MiB;
constexpr size_t WS_MN = 24 * MiB;
constexpr size_t WS_KV = 33 * MiB;
constexpr size_t WS_XN = 48 * MiB;
constexpr size_t WS_PA = 144 * MiB;
constexpr size_t WS_FO = 240 * MiB;
constexpr size_t WS_AB = 336 * MiB;
constexpr size_t WS_Q = 432 * MiB;
constexpr size_t WS_END = 480 * MiB;
constexpr size_t OUT_PVF = 0, OUT_Y1 = 96 * MiB, OUT_STASH = 0;

constexpr int RING_BYTES = 131072;
constexpr int TAB_OFF = RING_BYTES + 1024;
constexpr int LDS_BYTES = 147456;

__device__ __forceinline__ unsigned f2bf(float f) { unsigned u = __builtin_bit_cast(unsigned, f); return (u + 0x7fffu + ((u >> 16) & 1u)) >> 16; }
__device__ __forceinline__ unsigned pk2(float lo, float hi) { return f2bf(lo) | (f2bf(hi) << 16); }
__device__ __forceinline__ float bflo(unsigned u) { return __builtin_bit_cast(float, u << 16); }
__device__ __forceinline__ float bfhi(unsigned u) { return __builtin_bit_cast(float, u & 0xffff0000u); }
__device__ __forceinline__ unsigned cvt_pk_bf16(float lo, float hi) { unsigned r; asm volatile("v_cvt_pk_bf16_f32 %0, %1, %2" : "=v"(r) : "v"(lo), "v"(hi)); return r; }
__device__ __forceinline__ float sigmoid_f(float v) { return __builtin_amdgcn_rcpf(1.0f + __expf(-v)); }
__device__ __forceinline__ float silu_f(float v) { return v * sigmoid_f(v); }
__device__ __forceinline__ float wave_sum(float v) {
#pragma unroll
    for (int o = 1; o < 64; o <<= 1) v += __shfl_xor(v, o);
    return v;
}
__device__ __forceinline__ float wave_max(float v) {
#pragma unroll
    for (int o = 1; o < 64; o <<= 1) v = fmaxf(v, __shfl_xor(v, o));
    return v;
}
#define LDS_WAIT() asm volatile("s_waitcnt lgkmcnt(0)" ::: "memory")

namespace pg8 {
constexpr int BM = 256, BK = 64, HALF = 128, HTB = HALF * BK * 2, STAGE_BYTES = 8 * HTB, NXCD = 8, WGM = 8;
constexpr int KP = 1024;
constexpr size_t TSTEP = (size_t)BM * KP * 2;
__device__ __forceinline__ int lds_byte(int r, int c) { const int st = (r >> 4) * 2 + (c >> 5), rr = r & 15, cc = c & 31, ob = rr * 64 + cc * 2; return st * 1024 + (ob ^ (((ob >> 9) & 1) << 5)); }
__device__ __forceinline__ void stage_rc(int b, int& R, int& C) { const int st = b / 1024, sb = b % 1024, swz = sb ^ (((sb >> 9) & 1) << 5); R = (st >> 1) * 16 + swz / 64; C = (st & 1) * 32 + (swz % 64) / 2; }
__device__ __forceinline__ int perm32(int rho) { const int n = rho >> 4, i = rho & 15; return 8 * (i >> 2) + 4 * n + (i & 3); }

struct Unit { const char* A; const char* B; int nt, pm, pn, seg; };

__device__ __forceinline__ void tile_order(int L, int nM, int nN, int& pm, int& pn) {
    const int nwg = nM * nN; int wgid = L;
    { const int q = nwg / NXCD, r = nwg % NXCD, xcd = wgid % NXCD, off = wgid / NXCD; wgid = (xcd < r ? xcd * (q + 1) : r * (q + 1) + (xcd - r) * q) + off; }
    const int nig = WGM * nN, gid = wgid / nig, fm = gid * WGM, gsz = (nM - fm) < WGM ? (nM - fm) : WGM;
    pm = fm + ((wgid % nig) % gsz); pn = (wgid % nig) / gsz;
}

template <class Epi, class Sched, bool ALIGN_EPI, bool SP2>
__device__ __forceinline__ void gemm_phase(LAS unsigned char* lds, const Sched& S, const Epi& E) {
    const int tid = threadIdx.x, wid = __builtin_amdgcn_readfirstlane(tid >> 6), lane = tid & 63, wr = wid >> 2, wc = wid & 3, fr = lane & 15, fq = lane >> 4;
    unsigned voffA[2], voffB[2];
#pragma unroll
    for (int i = 0; i < 2; ++i) { int R, C; stage_rc(tid * 16 + i * 8192, R, C); const int Rb = Epi::PERM ? ((R & ~31) + perm32(R & 31)) : R;
        voffA[i] = (unsigned)(R * KP + C) * 2u; voffB[i] = (unsigned)(Rb * KP + C) * 2u; }
    const size_t kstep = (size_t)(BK * 2);
    const size_t hstep = (size_t)HALF * KP * 2;
    const unsigned ldsw = (unsigned)wid * 1024u;
    const int aoff = lds_byte(wr * 64 + fr, fq * 8), boff = lds_byte(wc * 32 + fr, fq * 8);
#define PG8_SA(b, h) (((b) * 2 + (h)) * HTB)
#define PG8_SB(b, h) ((4 + (b) * 2 + (h)) * HTB)
#define PG8_STAGE(bufoff, gbase, voff) do { _Pragma("unroll") for (int _i = 0; _i < 2; ++_i) \
        __builtin_amdgcn_global_load_lds((const unsigned*)((const char*)(gbase) + (voff)[_i]), (LAS unsigned*)(lds + (bufoff) + ldsw + _i * 8192), 16, 0, 0); } while (0)
#define PG8_LDA(dst, b, h) do { _Pragma("unroll") for (int m = 0; m < 4; ++m) _Pragma("unroll") for (int k = 0; k < 2; ++k) dst[m][k] = *(const LAS bf16x8*)(lds + PG8_SA(b, h) + aoff + m * 2048 + k * 1024); } while (0)
#define PG8_LDB(dst, b, h) do { _Pragma("unroll") for (int n = 0; n < 2; ++n) _Pragma("unroll") for (int k = 0; k < 2; ++k) dst[n][k] = *(const LAS bf16x8*)(lds + PG8_SB(b, h) + boff + n * 2048 + k * 1024); } while (0)
#define PG8_MMA(ai, bj, At, Bt) do { __builtin_amdgcn_s_setprio(1); _Pragma("unroll") for (int m = 0; m < 4; ++m) _Pragma("unroll") for (int n = 0; n < 2; ++n) _Pragma("unroll") for (int k = 0; k < 2; ++k) \
        acc[ai][bj][m][n] = __builtin_amdgcn_mfma_f32_16x16x32_bf16(Bt[n][k], At[m][k], acc[ai][bj][m][n], 0, 0, 0); __builtin_amdgcn_s_setprio(0); } while (0)
#define PG8_WAIT_V(n) asm volatile("s_waitcnt vmcnt(" #n ")" ::: "memory")
#define PG8_WAIT_L(n) asm volatile("s_waitcnt lgkmcnt(" #n ")" ::: "memory")
#define PG8_BAR __builtin_amdgcn_s_barrier()
#define PG8_SCHED __builtin_amdgcn_sched_barrier(0)
    Unit cur, nxt; int ui = 0;
    if (!S.next(0, cur)) return;
    f32x4 acc[2][2][4][2];
#pragma unroll
    for (int a = 0; a < 2; ++a)
#pragma unroll
        for (int b = 0; b < 2; ++b)
#pragma unroll
            for (int m = 0; m < 4; ++m)
#pragma unroll
                for (int n = 0; n < 2; ++n) acc[a][b][m][n] = (f32x4){0.f, 0.f, 0.f, 0.f};
    bf16x8 At[4][2], B0[2][2], B1[2][2];
    const char* cA = cur.A; const char* cB = cur.B;
    if constexpr (SP2) {
        PG8_STAGE(PG8_SB(0, 0), cB, voffB); PG8_STAGE(PG8_SB(0, 1), cB + hstep, voffB); PG8_STAGE(PG8_SA(0, 0), cA, voffA); PG8_STAGE(PG8_SA(0, 1), cA + hstep, voffA);
        if (wr == 1) PG8_BAR;
        PG8_WAIT_V(2); PG8_BAR;
        PG8_STAGE(PG8_SB(1, 0), cB + kstep, voffB); PG8_STAGE(PG8_SA(1, 0), cA + kstep, voffA); PG8_STAGE(PG8_SB(1, 1), cB + hstep + kstep, voffB);
        PG8_WAIT_V(6); PG8_BAR;
    } else {
        PG8_STAGE(PG8_SB(0, 0), cB, voffB); PG8_STAGE(PG8_SA(0, 0), cA, voffA); PG8_STAGE(PG8_SB(0, 1), cB + hstep, voffB); PG8_STAGE(PG8_SA(0, 1), cA + hstep, voffA);
        if (wr == 1) PG8_BAR;
        PG8_WAIT_V(4); PG8_BAR;
        PG8_STAGE(PG8_SB(1, 0), cB + kstep, voffB); PG8_STAGE(PG8_SA(1, 0), cA + kstep, voffA); PG8_STAGE(PG8_SB(1, 1), cB + hstep + kstep, voffB);
        PG8_WAIT_V(6); PG8_BAR;
    }
    for (;;) {
        const bool has_next = S.next(ui + 1, nxt);
        const char* nA = has_next ? nxt.A : cA; const char* nB = has_next ? nxt.B : cB;
        const int nt = cur.nt;
        for (int t = 0; t < nt; t += 2) {
            const bool last = (t == nt - 2);
            const char* a1 = cA + (size_t)(t + 1) * kstep;
            const char* a2 = last ? nA : cA + (size_t)(t + 2) * kstep; const char* b2 = last ? nB : cB + (size_t)(t + 2) * kstep;
            const char* a3 = a2 + kstep; const char* b3 = b2 + kstep;
            if constexpr (SP2) {
            PG8_LDB(B0, 0, 0); PG8_LDB(B1, 0, 1); PG8_SCHED; PG8_LDA(At, 0, 0); PG8_STAGE(PG8_SA(1, 1), a1 + hstep, voffA);
            PG8_WAIT_V(8); PG8_WAIT_L(0); PG8_BAR; PG8_MMA(0, 0, At, B0); PG8_MMA(0, 1, At, B1); PG8_BAR; PG8_SCHED;
            PG8_LDA(At, 0, 1); PG8_STAGE(PG8_SB(0, 0), b2, voffB); PG8_STAGE(PG8_SB(0, 1), b2 + hstep, voffB); PG8_STAGE(PG8_SA(0, 0), a2, voffA);
            PG8_WAIT_V(8); PG8_WAIT_L(0); PG8_BAR; PG8_MMA(1, 0, At, B0); PG8_MMA(1, 1, At, B1); PG8_BAR; PG8_SCHED;
            PG8_LDB(B0, 1, 0); PG8_LDB(B1, 1, 1); PG8_SCHED; PG8_LDA(At, 1, 0); PG8_STAGE(PG8_SA(0, 1), a2 + hstep, voffA);
            PG8_WAIT_V(8); PG8_WAIT_L(0); PG8_BAR; PG8_MMA(0, 0, At, B0); PG8_MMA(0, 1, At, B1); PG8_BAR; PG8_SCHED;
            PG8_LDA(At, 1, 1); PG8_STAGE(PG8_SB(1, 0), b3, voffB); PG8_STAGE(PG8_SB(1, 1), b3 + hstep, voffB); PG8_STAGE(PG8_SA(1, 0), a3, voffA);
            PG8_WAIT_V(8); PG8_WAIT_L(0); PG8_BAR; PG8_MMA(1, 0, At, B0); PG8_MMA(1, 1, At, B1); PG8_BAR; PG8_SCHED;
            } else {
            PG8_LDB(B0, 0, 0); PG8_SCHED; PG8_LDA(At, 0, 0); PG8_STAGE(PG8_SA(1, 1), a1 + hstep, voffA);
            PG8_WAIT_L(8); PG8_BAR; PG8_WAIT_L(0); PG8_MMA(0, 0, At, B0); PG8_BAR; PG8_SCHED;
            PG8_LDB(B1, 0, 1); PG8_STAGE(PG8_SB(0, 0), b2, voffB);
            PG8_BAR; PG8_WAIT_L(0); PG8_MMA(0, 1, At, B1); PG8_BAR;
            PG8_LDA(At, 0, 1); PG8_STAGE(PG8_SA(0, 0), a2, voffA);
            PG8_BAR; PG8_WAIT_L(0); PG8_MMA(1, 0, At, B0); PG8_BAR; PG8_SCHED;
            PG8_STAGE(PG8_SB(0, 1), b2 + hstep, voffB);
            PG8_WAIT_V(6); PG8_BAR; PG8_MMA(1, 1, At, B1); PG8_BAR;
            PG8_LDB(B0, 1, 0); PG8_SCHED; PG8_LDA(At, 1, 0); PG8_STAGE(PG8_SA(0, 1), a2 + hstep, voffA);
            PG8_WAIT_L(8); PG8_BAR; PG8_WAIT_L(0); PG8_MMA(0, 0, At, B0); PG8_BAR; PG8_SCHED;
            PG8_LDB(B1, 1, 1); PG8_STAGE(PG8_SB(1, 0), b3, voffB);
            PG8_BAR; PG8_WAIT_L(0); PG8_MMA(0, 1, At, B1); PG8_BAR;
            PG8_LDA(At, 1, 1); PG8_STAGE(PG8_SA(1, 0), a3, voffA);
            PG8_BAR; PG8_WAIT_L(0); PG8_MMA(1, 0, At, B0); PG8_BAR; PG8_SCHED;
            PG8_STAGE(PG8_SB(1, 1), b3 + hstep, voffB);
            PG8_WAIT_V(6); PG8_BAR; PG8_MMA(1, 1, At, B1); PG8_BAR;
            }
        }
        if constexpr (ALIGN_EPI) { if (wr == 0) PG8_BAR; }
        E(acc, cur, wr, wc, fr, fq);
        if (!has_next) break;
#pragma unroll
        for (int a = 0; a < 2; ++a)
#pragma unroll
            for (int b = 0; b < 2; ++b)
#pragma unroll
                for (int m = 0; m < 4; ++m)
#pragma unroll
                    for (int n = 0; n < 2; ++n) acc[a][b][m][n] = (f32x4){0.f, 0.f, 0.f, 0.f};
        cur = nxt; cA = nA; cB = nB; ++ui;
        if constexpr (ALIGN_EPI) { if (wr == 1) PG8_BAR; }
    }
    PG8_WAIT_V(0);
    if constexpr (!ALIGN_EPI) { if (wr == 0) PG8_BAR; }
    PG8_BAR;
#undef PG8_SA
#undef PG8_SB
#undef PG8_STAGE
#undef PG8_LDA
#undef PG8_LDB
#undef PG8_MMA
#undef PG8_WAIT_V
#undef PG8_WAIT_L
#undef PG8_BAR
#undef PG8_SCHED
}
}
using pg8::Unit;

struct Ctx {
    LAS unsigned char* lds;
    int tid, lane, wave, G, bid;
    const float *xp, *xs, *memp, *mems, *norm_in, *norm_mem, *w_in, *w_pool_grp, *pool_scale, *w_four_grp, *w_kv, *w_pool_out, *w_four_out, *w_attn_out, *b_gate, *w_o, *norm_f;
    float* out;
    bf16_t *W1T, *WGT, *WPOT, *WFAT, *WOT, *WKVT, *MN, *KV, *XN, *PA, *FO, *AB, *Q, *PVF, *Y1, *MERGED;
    unsigned char* stash;
};

struct SchedP1 {
    int G, c; const char *XN, *W1T, *MN, *WKVT;
    __device__ __forceinline__ bool next(int i, Unit& u) const {
        int L = i * G + c; u.nt = 16;
        if (L < 192 * 18) { pg8::tile_order(L, 192, 18, u.pm, u.pn); u.A = XN + (size_t)u.pm * pg8::TSTEP; u.B = W1T + (size_t)u.pn * pg8::TSTEP; u.seg = 0; return true; }
        L -= 192 * 18; if (L >= 17 * 4) return false;
        u.pm = L % 17; u.pn = L / 17; u.A = MN + (size_t)u.pm * pg8::TSTEP; u.B = WKVT + (size_t)u.pn * pg8::TSTEP; u.seg = 1; return true;
    }
};
struct EpiP1 {
    static constexpr bool PERM = true;
    bf16_t *PVF, *SPG, *AB, *FO, *Q, *KV;
    __device__ __forceinline__ void operator()(const f32x4 (&acc)[2][2][4][2], const Unit& u, int wr, int wc, int fr, int fq) const {
        bf16_t* base; int ld, colt, act; const int pn = u.pn;
        if (u.seg == 1) { base = KV; ld = 1024; colt = pn * 256; act = 0; }
        else if (pn < 4) { base = PVF; ld = 1024; colt = pn * 256; act = 0; }
        else if (pn < 8) { base = SPG; ld = 1024; colt = (pn - 4) * 256; act = 1; }
        else if (pn < 12) { base = AB; ld = 1024; colt = (pn - 8) * 256; act = 0; }
        else if (pn < 14) { base = FO; ld = 1024; colt = (pn - 12) * 256; act = 1; }
        else if (pn < 16) { base = Q; ld = 512; colt = (pn - 14) * 256; act = 0; }
        else { base = FO; ld = 1024; colt = 512 + (pn - 16) * 256; act = 1; }
        const int row0 = u.pm * 256 + wr * 64 + fr, col0 = colt + wc * 32 + 8 * fq;
#pragma unroll
        for (int ai = 0; ai < 2; ++ai)
#pragma unroll
            for (int m = 0; m < 4; ++m) { bf16_t* rowp = base + (size_t)(row0 + ai * 128 + m * 16) * ld + col0;
#pragma unroll
                for (int bj = 0; bj < 2; ++bj) { f32x4 v0 = acc[ai][bj][m][0], v1 = acc[ai][bj][m][1];
                    if (act) {
#pragma unroll
                        for (int j = 0; j < 4; ++j) { v0[j] = silu_f(v0[j]); v1[j] = silu_f(v1[j]); } }
                    u32x4 w; w.x = cvt_pk_bf16(v0[0], v0[1]); w.y = cvt_pk_bf16(v0[2], v0[3]); w.z = cvt_pk_bf16(v1[0], v1[1]); w.w = cvt_pk_bf16(v1[2], v1[3]);
                    *(u32x4*)(rowp + bj * 128) = w; } }
    }
};
struct SchedP3 {
    int G, c; const char *PA, *XN, *FO, *WPOT, *WGT, *WFAT;
    __device__ __forceinline__ bool next(int i, Unit& u) const {
        const int ti = i / 6, seg = i - 6 * ti, L = ti * G + c; if (L >= 192 * 4) return false;
        pg8::tile_order(L, 192, 4, u.pm, u.pn); u.seg = seg;
        const size_t am = (size_t)u.pm * pg8::TSTEP, bn = (size_t)u.pn * pg8::TSTEP;
        if (seg == 0) { u.A = PA + am; u.B = WPOT + bn; u.nt = 16; }
        else if (seg == 2) { u.A = FO + am; u.B = WFAT + bn; u.nt = 8; }
        else if (seg == 4) { u.A = FO + am + 1024; u.B = WFAT + bn + 1024; u.nt = 8; }
        else { u.A = XN + am; u.B = WGT + (size_t)(4 * (seg >> 1) + u.pn) * pg8::TSTEP; u.nt = 16; }
        return true;
    }
};
struct EpiP3 {
    static constexpr bool PERM = true;
    unsigned char* stash; const float* bgate; bf16_t* MERGED;
    __device__ __forceinline__ void operator()(const f32x4 (&acc)[2][2][4][2], const Unit& u, int wr, int wc, int fr, int fq) const {
        const int tid = threadIdx.x, seg = u.seg;
        const unsigned toff = (unsigned)tid * 16u; const __amdgpu_buffer_rsrc_t srs = __builtin_amdgcn_make_buffer_rsrc((void*)stash, (short)0, 262144, 0x00020000);
        if ((seg & 1) == 0) {
#pragma unroll
            for (int ai = 0; ai < 2; ++ai)
#pragma unroll
                for (int bj = 0; bj < 2; ++bj)
#pragma unroll
                    for (int m = 0; m < 4; ++m) { const f32x4 v0 = acc[ai][bj][m][0], v1 = acc[ai][bj][m][1];
                        u32x4 w; w.x = cvt_pk_bf16(v0[0], v0[1]); w.y = cvt_pk_bf16(v0[2], v0[3]); w.z = cvt_pk_bf16(v1[0], v1[1]); w.w = cvt_pk_bf16(v1[2], v1[3]);
                        __builtin_amdgcn_raw_buffer_store_b128(w, srs, toff, ((ai * 2 + bj) * 4 + m) * 8192, 0); }
        } else {
            const int bcol0 = (seg >> 1) * 1024 + u.pn * 256 + wc * 32 + 8 * fq;
            const int row0 = u.pm * 256 + wr * 64 + fr, col0 = u.pn * 256 + wc * 32 + 8 * fq;
#pragma unroll
            for (int bj = 0; bj < 2; ++bj) {
                const f32x4 b0 = *(const f32x4*)(bgate + bcol0 + bj * 128), b1 = *(const f32x4*)(bgate + bcol0 + bj * 128 + 4);
#pragma unroll
                for (int ai = 0; ai < 2; ++ai)
#pragma unroll
                    for (int m = 0; m < 4; ++m) { const int j = (ai * 2 + bj) * 4 + m;
                        const u32x4 yv = __builtin_amdgcn_raw_buffer_load_b128(srs, toff, j * 8192, 0);
                        const f32x4 a0 = acc[ai][bj][m][0] + b0, a1 = acc[ai][bj][m][1] + b1;
                        float r[8];
                        r[0] = sigmoid_f(a0[0]) * bflo(yv.x); r[1] = sigmoid_f(a0[1]) * bfhi(yv.x); r[2] = sigmoid_f(a0[2]) * bflo(yv.y); r[3] = sigmoid_f(a0[3]) * bfhi(yv.y);
                        r[4] = sigmoid_f(a1[0]) * bflo(yv.z); r[5] = sigmoid_f(a1[1]) * bfhi(yv.z); r[6] = sigmoid_f(a1[2]) * bflo(yv.w); r[7] = sigmoid_f(a1[3]) * bfhi(yv.w);
                        if (seg >= 3) { const u32x4 mv = __builtin_amdgcn_raw_buffer_load_b128(srs, toff, 131072 + j * 8192, 0);
                            r[0] += bflo(mv.x); r[1] += bfhi(mv.x); r[2] += bflo(mv.y); r[3] += bfhi(mv.y); r[4] += bflo(mv.z); r[5] += bfhi(mv.z); r[6] += bflo(mv.w); r[7] += bfhi(mv.w); }
                        u32x4 w; w.x = cvt_pk_bf16(r[0], r[1]); w.y = cvt_pk_bf16(r[2], r[3]); w.z = cvt_pk_bf16(r[4], r[5]); w.w = cvt_pk_bf16(r[6], r[7]);
                        if (seg < 5) __builtin_amdgcn_raw_buffer_store_b128(w, srs, toff, 131072 + j * 8192, 0);
                        else *(u32x4*)(MERGED + (size_t)(row0 + ai * 128 + m * 16) * 1024 + col0 + bj * 128) = w;
                        if (m & 1) asm volatile("" ::: "memory"); }
            }
        }
    }
};
struct SchedP4 {
    int G, c; const char *MERGED, *WOT;
    __device__ __forceinline__ bool next(int i, Unit& u) const {
        const int L = i * G + c; if (L >= 192 * 4) return false;
        pg8::tile_order(L, 192, 4, u.pm, u.pn); u.A = MERGED + (size_t)u.pm * pg8::TSTEP; u.B = WOT + (size_t)u.pn * pg8::TSTEP; u.nt = 16; u.seg = 0; return true;
    }
};
struct EpiP4 {
    static constexpr bool PERM = false;
    const float *xp, *xs; float* out;
    __device__ __forceinline__ void operator()(const f32x4 (&acc)[2][2][4][2], const Unit& u, int wr, int wc, int fr, int fq) const {
        const int row0 = u.pm * 256 + wr * 64 + fr, col0 = u.pn * 256 + wc * 32 + 4 * fq;
        const float* xb = (u.pm < MP / 256) ? xp : xs - (size_t)MP * DM;
#pragma unroll
        for (int ai = 0; ai < 2; ++ai)
#pragma unroll
            for (int m = 0; m < 4; ++m) { const size_t off = (size_t)(row0 + ai * 128 + m * 16) * DM + col0;
#pragma unroll
                for (int bj = 0; bj < 2; ++bj)
#pragma unroll
                    for (int n = 0; n < 2; ++n) { const f32x4 xv = *(const f32x4*)(xb + off + bj * 128 + n * 16); *(f32x4*)(out + off + bj * 128 + n * 16) = xv + acc[ai][bj][m][n]; }
                asm volatile("" ::: "memory"); }
    }
};

__device__ __forceinline__ void transpose_item(const float* W, int ldw, bf16_t* WT, int nblk, LAS float* scr, int item, int lane) {
    const int kb = item / nblk, nb = item % nblk, k0 = 64 * kb, n0 = 32 * nb;
#pragma unroll 8
    for (int i = 0; i < 32; ++i) { const int kk = 2 * i + (lane >> 5); scr[kk * 33 + (lane & 31)] = W[(size_t)(k0 + kk) * ldw + n0 + (lane & 31)]; }
    LDS_WAIT(); asm volatile("" ::: "memory");
    const int c = lane & 7;
#pragma unroll
    for (int j = 0; j < 4; ++j) { const int n = (lane >> 3) + 8 * j; const LAS float* s = scr + (8 * c) * 33 + n;
        u32x4 o; o.x = pk2(s[0 * 33], s[1 * 33]); o.y = pk2(s[2 * 33], s[3 * 33]); o.z = pk2(s[4 * 33], s[5 * 33]); o.w = pk2(s[6 * 33], s[7 * 33]);
        *(u32x4*)(WT + (size_t)(n0 + n) * 1024 + k0 + 8 * c) = o; }
    LDS_WAIT(); asm volatile("" ::: "memory");
}
__device__ __forceinline__ void rms_row_to_bf16(const float* xrow, const float* gain, bf16_t* orow, int lane) {
    const f32x4* xr = (const f32x4*)xrow + lane; const f32x4* gr = (const f32x4*)gain + lane;
    f32x4 v[4]; float s = 0.f;
#pragma unroll
    for (int j = 0; j < 4; ++j) { v[j] = xr[64 * j]; s += (v[j].x * v[j].x + v[j].y * v[j].y) + (v[j].z * v[j].z + v[j].w * v[j].w); }
    const float r = 1.0f / sqrtf(wave_sum(s) * (1.f / DM) + EPS);
    u32x2* o8 = (u32x2*)orow + lane;
#pragma unroll
    for (int j = 0; j < 4; ++j) { const f32x4 g = gr[64 * j]; u32x2 w; w.x = pk2(v[j].x * r * g.x, v[j].y * r * g.y); w.y = pk2(v[j].z * r * g.z, v[j].w * r * g.w); o8[64 * j] = w; }
}
__device__ __forceinline__ void fold_item(const Ctx& F, int item) {
    LAS float* As = (LAS float*)F.lds;
    LAS float* Bs = (LAS float*)(F.lds + 16384);
    LAS float* Ts = (LAS float*)(F.lds + 32768);
    const LAS f32x2* tab = (const LAS f32x2*)(F.lds + TAB_OFF);
    const int tid = F.tid, tk = tid & 63, tj = tid >> 6;
    float acc[8];
#pragma unroll
    for (int j = 0; j < 8; ++j) acc[j] = 0.f;
    if (item < 256) {
        const int g = item >> 6, k0 = ((item >> 2) & 15) * 64, j0 = (item & 3) * 64;
        for (int c0 = 0; c0 < 256; c0 += 32) {
            __syncthreads();
#pragma unroll
            for (int i = 0; i < 4; ++i) { const int idx = tid + 512 * i; { const int kk = idx >> 5, cc = idx & 31; As[kk * 33 + cc] = F.w_in[(size_t)(k0 + kk) * INW + g * 256 + c0 + cc]; }
                { const int cc = idx >> 6, jj = idx & 63; Bs[cc * 64 + jj] = F.w_pool_grp[(size_t)(g * 256 + c0 + cc) * 256 + j0 + jj]; } }
            __syncthreads();
#pragma unroll 8
            for (int cc = 0; cc < 32; ++cc) { const float a = As[tk * 33 + cc];
#pragma unroll
                for (int j = 0; j < 8; ++j) acc[j] += a * Bs[cc * 64 + tj * 8 + j]; }
        }
#pragma unroll
        for (int j = 0; j < 8; ++j) { const int n = g * 256 + j0 + tj * 8 + j; F.W1T[(size_t)n * 1024 + k0 + tk] = (bf16_t)f2bf(acc[j] * F.pool_scale[n]); }
    } else {
        const int it = item - 256, g = it >> 6, sn = (it >> 5) & 1, k0 = ((it >> 1) & 15) * 64, j0 = (it & 1) * 64;
        __syncthreads();
        { const int c = tid & 127, jq = tid >> 7; float t[16];
#pragma unroll
            for (int j = 0; j < 16; ++j) t[j] = 0.f;
            for (int d = 0; d < 128; ++d) { const f32x2 cs = tab[(c * d) & 127]; const float w = sn ? cs.y : cs.x;
                const f32x4* wp = (const f32x4*)(F.w_four_grp + (size_t)(g * 128 + d) * 128 + j0 + jq * 16);
#pragma unroll
                for (int q = 0; q < 4; ++q) { const f32x4 x = wp[q]; t[4 * q] += w * x.x; t[4 * q + 1] += w * x.y; t[4 * q + 2] += w * x.z; t[4 * q + 3] += w * x.w; } }
#pragma unroll
            for (int j = 0; j < 16; ++j) Ts[c * 64 + jq * 16 + j] = t[j] * 0.08838834764831845f; }
        for (int c0 = 0; c0 < 128; c0 += 32) {
            __syncthreads();
#pragma unroll
            for (int i = 0; i < 4; ++i) { const int idx = tid + 512 * i; const int kk = idx >> 5, cc = idx & 31; As[kk * 33 + cc] = F.w_in[(size_t)(k0 + kk) * INW + 2048 + g * 128 + c0 + cc]; }
            __syncthreads();
#pragma unroll 8
            for (int cc = 0; cc < 32; ++cc) { const float a = As[tk * 33 + cc];
#pragma unroll
                for (int j = 0; j < 8; ++j) acc[j] += a * Ts[(c0 + cc) * 64 + tj * 8 + j]; }
        }
#pragma unroll
        for (int j = 0; j < 8; ++j) { const int n = 2048 + sn * 512 + g * 128 + j0 + tj * 8 + j; F.W1T[(size_t)n * 1024 + k0 + tk] = (bf16_t)f2bf(acc[j]); }
    }
    __syncthreads();
}
__device__ __forceinline__ void p0_prologue(const Ctx& F) {
    for (int it = F.bid; it < 512; it += F.G) fold_item(F, it);
    __syncthreads();
    LAS float* scr = (LAS float*)(F.lds + F.wave * 16384);
    const int gw = F.bid * NWAVES + F.wave, NGW = F.G * NWAVES;
    constexpr int I0 = 16 * 32, I1 = 16 * 16, I4 = 16 * 96, I5 = 16 * 32, I6 = 8 * 32;
    constexpr int NITEMS = I0 + 3 * I1 + I4 + I5 + 2 * I6 + 2 * I5;
    for (int it = gw; it < NITEMS; it += NGW) {
        int r = it;
        if (r < I0) { transpose_item(F.w_in + 1024, INW, F.W1T + (size_t)1024 * 1024, 32, scr, r, F.lane); continue; } r -= I0;
        if (r < I1) { transpose_item(F.w_in + 2560, INW, F.W1T + (size_t)3072 * 1024, 16, scr, r, F.lane); continue; } r -= I1;
        if (r < I1) { transpose_item(F.w_in + 3072, INW, F.W1T + (size_t)3584 * 1024, 16, scr, r, F.lane); continue; } r -= I1;
        if (r < I1) { transpose_item(F.w_in + 3584, INW, F.W1T + (size_t)4096 * 1024, 16, scr, r, F.lane); continue; } r -= I1;
        if (r < I4) { transpose_item(F.w_in + 4096, INW, F.WGT, 96, scr, r, F.lane); continue; } r -= I4;
        if (r < I5) { transpose_item(F.w_pool_out, 1024, F.WPOT, 32, scr, r, F.lane); continue; } r -= I5;
        if (r < I6) { transpose_item(F.w_four_out, 1024, F.WFAT, 32, scr, r, F.lane); continue; } r -= I6;
        if (r < I6) { transpose_item(F.w_attn_out, 1024, F.WFAT + 512, 32, scr, r, F.lane); continue; } r -= I6;
        if (r < I5) { transpose_item(F.w_o, 1024, F.WOT, 32, scr, r, F.lane); continue; } r -= I5;
        transpose_item(F.w_kv, 1024, F.WKVT, 32, scr, r, F.lane);
    }
    for (int m = gw; m < MT + MMEM; m += NGW) {
        if (m < MP) rms_row_to_bf16(F.xp + (size_t)m * DM, F.norm_in, F.XN + (size_t)m * DM, F.lane);
        else if (m < MT) rms_row_to_bf16(F.xs + (size_t)(m - MP) * DM, F.norm_in, F.XN + (size_t)m * DM, F.lane);
        else { const int r = m - MT; const float* src = r < 16 * NMEM ? F.memp + (size_t)r * DM : F.mems + (size_t)(r - 16 * NMEM) * DM; rms_row_to_bf16(src, F.norm_mem, F.MN + (size_t)r * DM, F.lane); }
    }
}

__device__ __forceinline__ void seq_of_row(int row, int& r0, int& S) { if (row < MP) { r0 = row & ~2047; S = 2048; } else { r0 = MP; S = MS; } }
__device__ __forceinline__ void pool_phase(const Ctx& F) {
    const long total = (long)MT * 128;
    for (long it = (long)F.bid * NTHR + F.tid; it < total; it += (long)F.G * NTHR) {
        const int row = (int)(it >> 7), ch = (int)(it & 127), col = ch * 8, g = ch >> 5, half = 1 << g;
        int r0, S; seq_of_row(row, r0, S);
        const int t = row - r0, lo = t - half < 0 ? 0 : t - half, hi = t + half > S ? S : t + half;
        float s[8];
#pragma unroll
        for (int j = 0; j < 8; ++j) s[j] = 0.f;
        for (int i = lo; i < hi; ++i) { const u32x4 v = *(const u32x4*)(F.PVF + (size_t)(r0 + i) * 1024 + col);
            s[0] += bflo(v.x); s[1] += bfhi(v.x); s[2] += bflo(v.y); s[3] += bfhi(v.y); s[4] += bflo(v.z); s[5] += bfhi(v.z); s[6] += bflo(v.w); s[7] += bfhi(v.w); }
        const float inv = 1.0f / (float)(hi - lo);
        const u32x4 me = *(const u32x4*)(F.PVF + (size_t)row * 1024 + col); const u32x4 gt = *(const u32x4*)(F.PA + (size_t)row * 1024 + col);
        u32x4 o;
        o.x = pk2((s[0] * inv - bflo(me.x)) * bflo(gt.x), (s[1] * inv - bfhi(me.x)) * bfhi(gt.x));
        o.y = pk2((s[2] * inv - bflo(me.y)) * bflo(gt.y), (s[3] * inv - bfhi(me.y)) * bfhi(gt.y));
        o.z = pk2((s[4] * inv - bflo(me.z)) * bflo(gt.z), (s[5] * inv - bfhi(me.z)) * bfhi(gt.z));
        o.w = pk2((s[6] * inv - bflo(me.w)) * bflo(gt.w), (s[7] * inv - bfhi(me.w)) * bfhi(gt.w));
        *(u32x4*)(F.PA + (size_t)row * 1024 + col) = o;
    }
}
__device__ __forceinline__ void dft1_phase(const Ctx& F) {
    const LAS f32x2* tab = (const LAS f32x2*)(F.lds + TAB_OFF);
    for (int it = F.bid; it < 16384 + 8192; it += F.G) {
        int seq, s2, head, chk, N1, r0, S, sh;
        if (it < 16384) { seq = it >> 10; const int r = it & 1023; s2 = r >> 3; head = (r >> 1) & 3; chk = r & 1; N1 = 16; r0 = seq * 2048; S = 2048; sh = 3; }
        else { const int r = it - 16384; seq = 16; s2 = r >> 6; head = (r >> 4) & 3; chk = r & 15; N1 = 128; r0 = MP; S = MS; sh = 0; }
        const int k1 = chk * 8 + (F.tid >> 6), col = head * 128 + 2 * (F.tid & 63);
        float yr0 = 0.f, yr1 = 0.f, yi0 = 0.f, yi1 = 0.f;
        for (int s1 = 0; s1 < N1; ++s1) {
            const size_t ro = (size_t)(r0 + 128 * s1 + s2) * 1024 + col;
            const unsigned av = *(const unsigned*)(F.AB + ro), bv = *(const unsigned*)(F.AB + ro + 512);
            const f32x2 cs = tab[((k1 * s1) << sh) & 127];
            const float a0 = bflo(av), a1 = bfhi(av), b0 = bflo(bv), b1 = bfhi(bv);
            yr0 += cs.x * a0 - cs.y * b0; yi0 += cs.y * a0 + cs.x * b0;
            yr1 += cs.x * a1 - cs.y * b1; yi1 += cs.y * a1 + cs.x * b1;
        }
        float tc, ts; { const float ang = 2.0f * (float)(k1 * s2) / (float)S; ts = sinpif(ang); tc = cospif(ang); }
        const float sc = N1 == 16 ? 0.25f : 0.08838834764831845f; tc *= sc; ts *= sc;
        const size_t wo = (size_t)(r0 + 128 * k1 + s2) * 1024 + col;
        *(unsigned*)(F.Y1 + wo) = pk2(yr0 * tc - yi0 * ts, yr1 * tc - yi1 * ts);
        *(unsigned*)(F.Y1 + wo + 512) = pk2(yr0 * ts + yi0 * tc, yr1 * ts + yi1 * tc);
    }
}
__device__ __forceinline__ void dft2_phase(const Ctx& F) {
    const LAS f32x2* tab = (const LAS f32x2*)(F.lds + TAB_OFF);
    for (int it = F.bid; it < 16384 + 8192; it += F.G) {
        int seq, k1, head, chk, N1, r0;
        if (it < 16384) { seq = it >> 10; const int r = it & 1023; k1 = r >> 6; head = (r >> 4) & 3; chk = r & 15; N1 = 16; r0 = seq * 2048; }
        else { const int r = it - 16384; seq = 16; k1 = r >> 6; head = (r >> 4) & 3; chk = r & 15; N1 = 128; r0 = MP; }
        const int k2 = chk * 8 + (F.tid >> 6), col = head * 128 + 2 * (F.tid & 63);
        float f0 = 0.f, f1 = 0.f;
        for (int s2 = 0; s2 < 128; ++s2) {
            const size_t ro = (size_t)(r0 + 128 * k1 + s2) * 1024 + col;
            const unsigned rv = *(const unsigned*)(F.Y1 + ro), iv = *(const unsigned*)(F.Y1 + ro + 512);
            const f32x2 cs = tab[(k2 * s2) & 127];
            f0 += cs.x * bflo(rv) - cs.y * bflo(iv); f1 += cs.x * bfhi(rv) - cs.y * bfhi(iv);
        }
        const size_t wo = (size_t)(r0 + k1 + N1 * k2) * 1024 + col;
        const unsigned gt = *(const unsigned*)(F.FO + wo);
        *(unsigned*)(F.FO + wo) = pk2(f0 * 0.08838834764831845f * bflo(gt), f1 * 0.08838834764831845f * bfhi(gt));
    }
}
__device__ __forceinline__ void attn_phase_simple(const Ctx& F) {
    const int gw = F.bid * NWAVES + F.wave, NGW = F.G * NWAVES, lane = F.lane;
    for (int it = gw; it < MT * 4; it += NGW) {
        const int row = it >> 2, h = it & 3, seq = row < MP ? row >> 11 : 16;
        const bf16_t* q = F.Q + (size_t)row * 512 + h * 128;
        const bf16_t* Kb = F.KV + (size_t)(seq * NMEM) * 1024 + h * 128;
        const bf16_t* Vb = Kb + 512;
        float s[4] = {0.f, 0.f, 0.f, 0.f};
        for (int d = 0; d < 128; d += 8) {
            const u32x4 qv = *(const u32x4*)(q + d);
            const float q0 = bflo(qv.x), q1 = bfhi(qv.x), q2 = bflo(qv.y), q3 = bfhi(qv.y), q4 = bflo(qv.z), q5 = bfhi(qv.z), q6 = bflo(qv.w), q7 = bfhi(qv.w);
#pragma unroll
            for (int i = 0; i < 4; ++i) { const u32x4 kv = *(const u32x4*)(Kb + (size_t)(lane + 64 * i) * 1024 + d);
                s[i] += q0 * bflo(kv.x) + q1 * bfhi(kv.x) + q2 * bflo(kv.y) + q3 * bfhi(kv.y) + q4 * bflo(kv.z) + q5 * bfhi(kv.z) + q6 * bflo(kv.w) + q7 * bfhi(kv.w); }
        }
        const float scale = 0.08838834764831845f;
#pragma unroll
        for (int i = 0; i < 4; ++i) s[i] *= scale;
        const float mx = wave_max(fmaxf(fmaxf(s[0], s[1]), fmaxf(s[2], s[3])));
        float p[4], l = 0.f;
#pragma unroll
        for (int i = 0; i < 4; ++i) { p[i] = __expf(s[i] - mx); l += p[i]; }
        l = wave_sum(l);
        float o0 = 0.f, o1 = 0.f;
#pragma unroll
        for (int i = 0; i < 4; ++i)
            for (int kk = 0; kk < 64; ++kk) { const float pk = __shfl(p[i], kk); const unsigned vv = *(const unsigned*)(Vb + (size_t)(64 * i + kk) * 1024 + 2 * lane); o0 += pk * bflo(vv); o1 += pk * bfhi(vv); }
        const float rl = 1.0f / l;
        unsigned* dst = (unsigned*)(F.FO + (size_t)row * 1024 + 512 + h * 128 + 2 * lane);
        const unsigned gt = *dst;
        *dst = pk2(o0 * rl * bflo(gt), o1 * rl * bfhi(gt));
    }
}

namespace att {
using bf16 = unsigned short;
using s16x4  = __attribute__((ext_vector_type(4))) short;
using f32x16 = __attribute__((ext_vector_type(16))) float;
constexpr int D = 128, NW = 8, QBLK = 32, KVBLK = 64;
constexpr float SCALE = 0.088388347648318440f;
constexpr float THR = 8.f;
constexpr int SDEPTH = 2;
constexpr int LDQ = 512, LDK = 1024, LDO = 1024;
constexpr size_t SHM_V = KVBLK * D * 2, SHM_K = KVBLK * D * 2, SHM_ATTN = 2 * SHM_V + 2 * SHM_K + NW * 64 * 4;
#define KSWZ(row, colB) ((row) * 256 + ((colB) ^ (((row) & 7) << 4)))
#define SBAR() __builtin_amdgcn_sched_barrier(0)
__device__ __forceinline__ int crow(int r, int hi) { return (r & 3) + 8 * (r >> 2) + 4 * hi; }
__device__ __forceinline__ unsigned cvtpk(float lo, float hi) { unsigned r; asm volatile("v_cvt_pk_bf16_f32 %0, %1, %2" : "=v"(r) : "v"(lo), "v"(hi)); return r; }
__device__ __forceinline__ bf16x8 ld8(const bf16* p) { return *reinterpret_cast<const bf16x8*>(p); }
__device__ __forceinline__ void partialSM(f32x16& p0, f32x16& p1, float& m_reg, float& mn, float& alpha) {
  constexpr float C = SCALE * 1.4426950408889634f;
  float pmax = p0[0]; for (int r = 1; r < 16; ++r) pmax = fmaxf(pmax, p0[r]); for (int r = 0; r < 16; ++r) pmax = fmaxf(pmax, p1[r]);
  { auto rr = __builtin_amdgcn_permlane32_swap(__float_as_uint(pmax), __float_as_uint(pmax), false, false);
    pmax = fmaxf(__uint_as_float(rr[0]), __uint_as_float(rr[1])); }
  if (__builtin_expect(__all(pmax - m_reg <= THR / SCALE), 1)) { mn = m_reg; alpha = 1.f; }
  else { mn = fmaxf(m_reg, pmax); alpha = __builtin_amdgcn_exp2f((m_reg - mn) * C); m_reg = mn; }
  float mnC = -mn * C;
  for (int r = 0; r < 16; ++r) p0[r] = fmaf(p0[r], C, mnC); for (int r = 0; r < 16; ++r) p1[r] = fmaf(p1[r], C, mnC);
  for (int r = 0; r < 16; ++r) p0[r] = __builtin_amdgcn_exp2f(p0[r]);
}
__device__ __forceinline__ void finishSM(f32x16& p0, f32x16& p1, float alpha, float& l_reg, bf16x8& pa0, bf16x8& pa1, bf16x8& pa2, bf16x8& pa3) {
  for (int r = 0; r < 16; ++r) p1[r] = __builtin_amdgcn_exp2f(p1[r]);
  float ps = 0; for (int r = 0; r < 16; ++r) ps += p0[r]; for (int r = 0; r < 16; ++r) ps += p1[r];
  { auto rr = __builtin_amdgcn_permlane32_swap(__float_as_uint(ps), __float_as_uint(ps), false, false);
    ps = __uint_as_float(rr[0]) + __uint_as_float(rr[1]); }
  l_reg = l_reg * alpha + ps;
#define PK4(P, BASE, OUT) do { unsigned a0 = cvtpk(P[BASE + 0], P[BASE + 1]), a1 = cvtpk(P[BASE + 2], P[BASE + 3]);   \
    unsigned b0 = cvtpk(P[BASE + 4], P[BASE + 5]), b1 = cvtpk(P[BASE + 6], P[BASE + 7]);                              \
    auto r0 = __builtin_amdgcn_permlane32_swap(a0, b0, false, false); auto r1 = __builtin_amdgcn_permlane32_swap(a1, b1, false, false); \
    u32x4 w = {r0[0], r1[0], r0[1], r1[1]}; OUT = *reinterpret_cast<bf16x8*>(&w); } while (0)
  PK4(p0, 0, pa0); PK4(p0, 8, pa1); PK4(p1, 0, pa2); PK4(p1, 8, pa3);
#undef PK4
}
__device__ __forceinline__ void qkt(f32x16& p0, f32x16& p1, const bf16* Ks, const bf16x8* qr, int r32, int hi) {
  p0 = f32x16{}; p1 = f32x16{};
  for (int d0 = 0; d0 < 8; ++d0) { int cb = (d0 * 16 + hi * 8) * 2;
    bf16x8 b0 = *reinterpret_cast<const bf16x8*>((const char*)Ks + KSWZ(r32, cb));
    bf16x8 b1 = *reinterpret_cast<const bf16x8*>((const char*)Ks + KSWZ(32 + r32, cb));
    p0 = __builtin_amdgcn_mfma_f32_32x32x16_bf16(b0, qr[d0], p0, 0, 0, 0);
    p1 = __builtin_amdgcn_mfma_f32_32x32x16_bf16(b1, qr[d0], p1, 0, 0, 0); }
}
__device__ __forceinline__ int v_st(int k, int c) { const int kk = (k & ~0xC) | ((k & 4) << 1) | ((k & 8) >> 1); return ((kk >> 3) * 4 + (c >> 5)) * 512 + ((kk & 7) * 32 + (c & 31)) * 2; }
__device__ __forceinline__ int v_rd_base(int lane) { return ((lane & 3) << 3) | (((lane >> 2) & 3) << 6) | (((lane >> 4) & 1) << 5) | (((lane >> 5) & 1) << 8); }
constexpr int v_rd_off(int d0, int ks, int half) { return d0 * 512 + ks * 4096 + half * 2048; }
template <int OFF> __device__ __forceinline__ s16x4 tr_read(int vb) {
  s16x4 r; asm volatile("ds_read_b64_tr_b16 %0, %1 offset:%2" : "=&v"(r) : "v"(vb), "i"(OFF) : "memory"); return r;
}
template <int D0> __device__ __forceinline__ void pv_one(f32x16& od, int vb, bf16x8 pa0, bf16x8 pa1, bf16x8 pa2, bf16x8 pa3) {
  const s16x4 l0 = tr_read<v_rd_off(D0, 0, 0)>(vb), h0 = tr_read<v_rd_off(D0, 0, 1)>(vb), l1 = tr_read<v_rd_off(D0, 1, 0)>(vb), h1 = tr_read<v_rd_off(D0, 1, 1)>(vb);
  const s16x4 l2 = tr_read<v_rd_off(D0, 2, 0)>(vb), h2 = tr_read<v_rd_off(D0, 2, 1)>(vb), l3 = tr_read<v_rd_off(D0, 3, 0)>(vb), h3 = tr_read<v_rd_off(D0, 3, 1)>(vb);
  asm volatile("s_waitcnt lgkmcnt(0)" ::: "memory"); SBAR();
#define PK(L, H) (bf16x8){L[0], L[1], L[2], L[3], H[0], H[1], H[2], H[3]}
  od = __builtin_amdgcn_mfma_f32_32x32x16_bf16(pa0, PK(l0, h0), od, 0, 0, 0);
  od = __builtin_amdgcn_mfma_f32_32x32x16_bf16(pa1, PK(l1, h1), od, 0, 0, 0);
  od = __builtin_amdgcn_mfma_f32_32x32x16_bf16(pa2, PK(l2, h2), od, 0, 0, 0);
  od = __builtin_amdgcn_mfma_f32_32x32x16_bf16(pa3, PK(l3, h3), od, 0, 0, 0);
#undef PK
}
__device__ __forceinline__ void pv_d0(f32x16* o, int vb, bf16x8 pa0, bf16x8 pa1, bf16x8 pa2, bf16x8 pa3) {
  pv_one<0>(o[0], vb, pa0, pa1, pa2, pa3); pv_one<1>(o[1], vb, pa0, pa1, pa2, pa3); pv_one<2>(o[2], vb, pa0, pa1, pa2, pa3); pv_one<3>(o[3], vb, pa0, pa1, pa2, pa3);
}
__device__ __forceinline__ void attn_unit(const bf16* __restrict__ Qb, const bf16* __restrict__ Kh, const bf16* __restrict__ Vh, bf16* __restrict__ Ob, int seq, char* lds) {
  const int tid = threadIdx.x, wid = tid >> 6, lane = tid & 63, r32 = lane & 31, hi = lane >> 5;
  bf16* V_lds = (bf16*)lds; bf16* K_lds = (bf16*)(lds + 2 * SHM_V);
  float* ws = (float*)(lds + 2 * SHM_V + 2 * SHM_K) + wid * 64; float* li_l = ws; float* al_l = ws + 32;
  float m_reg = -1e30f, l_reg = 0; f32x16 o[4] = {}; bf16x8 qr[8];
  const bf16* Qw = Qb + (long)(wid * QBLK + r32) * LDQ + hi * 8;
#pragma unroll
  for (int d0 = 0; d0 < 8; ++d0) qr[d0] = ld8(Qw + d0 * 16);
  const int sr = tid >> 4, sc = (tid & 15) * 8, vst0 = v_st(sr, sc), vst1 = v_st(32 + sr, sc);
  const int vb0 = (int)(uintptr_t)V_lds + v_rd_base(lane);
  struct { bf16x8 vs0, vs1, ks0, ks1; } sr_[SDEPTH];
#define SLOAD(i, k0) do { sr_[i].vs0 = ld8(&Vh[(long)((k0) + sr) * LDK + sc]); sr_[i].vs1 = ld8(&Vh[(long)((k0) + 32 + sr) * LDK + sc]); \
    sr_[i].ks0 = ld8(&Kh[(long)((k0) + sr) * LDK + sc]); sr_[i].ks1 = ld8(&Kh[(long)((k0) + 32 + sr) * LDK + sc]); } while (0)
#define SWRITE(b, i) do { *(bf16x8*)((char*)V_lds + (b) * SHM_V + vst0) = sr_[i].vs0;          \
    *(bf16x8*)((char*)V_lds + (b) * SHM_V + vst1) = sr_[i].vs1; int kc = sc * 2;               \
    *(bf16x8*)((char*)K_lds + (b) * SHM_K + KSWZ(sr, kc)) = sr_[i].ks0;                       \
    *(bf16x8*)((char*)K_lds + (b) * SHM_K + KSWZ(32 + sr, kc)) = sr_[i].ks1; } while (0)
#define SWAIT() asm volatile("s_waitcnt vmcnt(4)" ::: "memory")
#define RESC(a) do { if (__any((a) < 1.f)) { if (hi == 0) al_l[r32] = (a); asm volatile("s_waitcnt lgkmcnt(0)" ::: "memory"); \
    for (int d = 0; d < 4; ++d) for (int r = 0; r < 16; ++r) o[d][r] *= al_l[crow(r, hi)]; } } while (0)
  f32x16 pA0, pA1, pB0, pB1; float mnA, mnB, alA, alB; bf16x8 pa0, pa1, pa2, pa3; const int NT = seq / KVBLK;
  constexpr int SE = 0, SO = SDEPTH - 1;
  SLOAD(SE, 0); asm volatile("s_waitcnt vmcnt(0)" ::: "memory"); SWRITE(0, SE); __syncthreads();
  qkt(pA0, pA1, K_lds, qr, r32, hi); partialSM(pA0, pA1, m_reg, mnA, alA);
  SLOAD(SO, KVBLK); if (2 < NT) SLOAD(SE, 2 * KVBLK);
  SWAIT(); SWRITE(1, SO); __syncthreads();
  for (int j = 1; j + 1 < NT; j += 2) {
    SBAR(); qkt(pB0, pB1, (bf16*)((char*)K_lds + SHM_K), qr, r32, hi);
    finishSM(pA0, pA1, alA, l_reg, pa0, pa1, pa2, pa3); SBAR();
    SLOAD(SO, (j + SDEPTH) * KVBLK); SBAR();
    pv_d0(o, vb0, pa0, pa1, pa2, pa3); partialSM(pB0, pB1, m_reg, mnB, alB);
    __syncthreads(); SWAIT(); SWRITE(0, SE);
    RESC(alB); __syncthreads();
    SBAR(); qkt(pA0, pA1, K_lds, qr, r32, hi);
    finishSM(pB0, pB1, alB, l_reg, pa0, pa1, pa2, pa3); SBAR();
    if (j + 3 < NT) SLOAD(SE, (j + 1 + SDEPTH) * KVBLK); SBAR();
    pv_d0(o, vb0 + (int)SHM_V, pa0, pa1, pa2, pa3); partialSM(pA0, pA1, m_reg, mnA, alA);
    __syncthreads(); SWAIT(); SWRITE(1, SO);
    RESC(alA); __syncthreads();
  }
  SBAR(); qkt(pB0, pB1, (bf16*)((char*)K_lds + SHM_K), qr, r32, hi);
  finishSM(pA0, pA1, alA, l_reg, pa0, pa1, pa2, pa3); SBAR();
  pv_d0(o, vb0, pa0, pa1, pa2, pa3); partialSM(pB0, pB1, m_reg, mnB, alB);
  __syncthreads(); RESC(alB);
  finishSM(pB0, pB1, alB, l_reg, pa0, pa1, pa2, pa3); SBAR();
  pv_d0(o, vb0 + (int)SHM_V, pa0, pa1, pa2, pa3);
  if (hi == 0) li_l[r32] = l_reg; asm volatile("s_waitcnt lgkmcnt(0)" ::: "memory");
  float rli[16];
#pragma unroll
  for (int r = 0; r < 16; ++r) rli[r] = __builtin_amdgcn_rcpf(li_l[crow(r, hi)]);
  bf16* Ow = Ob + (long)(wid * QBLK) * LDO;
#pragma unroll
  for (int r = 0; r < 16; ++r) { int orow = crow(r, hi);
    for (int d0 = 0; d0 < 4; ++d0) { bf16* p = Ow + (long)orow * LDO + d0 * 32 + r32; const float g = __uint_as_float((unsigned)(*p) << 16); *p = (bf16)f2bf(o[d0][r] * rli[r] * g); } }
  __syncthreads();
#undef SLOAD
#undef SWRITE
#undef SWAIT
#undef RESC
}
#undef KSWZ
#undef SBAR
}
__device__ __forceinline__ void attn_phase_mfma(const Ctx& F, char* ldsg) {
    for (int u = F.bid; u < (MT / 256) * 4; u += F.G) {
        const int rb = u >> 2, h = u & 3, row0 = rb * 256, seq = row0 < MP ? row0 >> 11 : 16;
        const bf16_t* Kh = F.KV + (size_t)(seq * NMEM) * 1024 + h * 128;
        att::attn_unit(F.Q + (size_t)row0 * 512 + h * 128, Kh, Kh + 512, F.FO + (size_t)row0 * 1024 + 512 + h * 128, NMEM, ldsg);
    }
}
__device__ __forceinline__ void final_norm_phase(const Ctx& F) {
    const int gw = F.bid * NWAVES + F.wave, NGW = F.G * NWAVES;
    for (int m = gw; m < MT; m += NGW) {
        f32x4* xr = (f32x4*)(F.out + (size_t)m * DM) + F.lane; const f32x4* gr = (const f32x4*)F.norm_f + F.lane;
        f32x4 v[4]; float s = 0.f;
#pragma unroll
        for (int j = 0; j < 4; ++j) { v[j] = xr[64 * j]; s += (v[j].x * v[j].x + v[j].y * v[j].y) + (v[j].z * v[j].z + v[j].w * v[j].w); }
        const float r = 1.0f / sqrtf(wave_sum(s) * (1.f / DM) + EPS);
#pragma unroll
        for (int j = 0; j < 4; ++j) { const f32x4 g = gr[64 * j]; xr[64 * j] = v[j] * r * g; }
    }
}

struct Args { const float* in[17]; float* out; unsigned char* ws; int ph_lo, ph_hi; };
constexpr int N_PHASES = 7;
__global__ void __launch_bounds__(NTHR, 2) fwd(Args args) {
    extern __shared__ __attribute__((aligned(16))) unsigned char lds_[];
    cg::grid_group grid = cg::this_grid();
    Ctx F;
    F.lds = (LAS unsigned char*)lds_;
    F.tid = threadIdx.x; F.lane = F.tid & 63; F.wave = __builtin_amdgcn_readfirstlane(F.tid >> 6); F.G = gridDim.x; F.bid = blockIdx.x;
    F.xp = args.in[0]; F.xs = args.in[1]; F.memp = args.in[2]; F.mems = args.in[3]; F.norm_in = args.in[4]; F.norm_mem = args.in[5]; F.w_in = args.in[6]; F.w_pool_grp = args.in[7];
    F.pool_scale = args.in[8]; F.w_four_grp = args.in[9]; F.w_kv = args.in[10]; F.w_pool_out = args.in[11]; F.w_four_out = args.in[12]; F.w_attn_out = args.in[13]; F.b_gate = args.in[14];
    F.w_o = args.in[15]; F.norm_f = args.in[16]; F.out = args.out;
    unsigned char* ws = args.ws; unsigned char* ob = (unsigned char*)args.out;
    F.W1T = (bf16_t*)(ws + WS_W1T); F.WGT = (bf16_t*)(ws + WS_WGT); F.WPOT = (bf16_t*)(ws + WS_WPOT); F.WFAT = (bf16_t*)(ws + WS_WFAT); F.WOT = (bf16_t*)(ws + WS_WOT); F.WKVT = (bf16_t*)(ws + WS_WKVT);
    F.MN = (bf16_t*)(ws + WS_MN); F.KV = (bf16_t*)(ws + WS_KV); F.XN = (bf16_t*)(ws + WS_XN); F.PA = (bf16_t*)(ws + WS_PA); F.FO = (bf16_t*)(ws + WS_FO); F.AB = (bf16_t*)(ws + WS_AB);
    F.Q = (bf16_t*)(ws + WS_Q); F.PVF = (bf16_t*)(ob + OUT_PVF); F.Y1 = (bf16_t*)(ob + OUT_Y1); F.MERGED = (bf16_t*)(ws + WS_AB);
    F.stash = ob + OUT_STASH + (size_t)blockIdx.x * 262144;
    if (F.tid < 128) { LAS f32x2* tab = (LAS f32x2*)(F.lds + TAB_OFF); f32x2 v; v.x = cospif((float)F.tid * (1.0f / 64.0f)); v.y = sinpif((float)F.tid * (1.0f / 64.0f)); tab[F.tid] = v; }
    __syncthreads();
    const int lo = args.ph_lo, hi = args.ph_hi;
#define IN(k) (lo <= (k) && (k) < hi)
#define SEAM(k) do { if (IN(k) && IN((k) + 1)) grid.sync(); } while (0)
    if (IN(0)) { p0_prologue(F); }
    SEAM(0);
    if (IN(1)) {
        SchedP1 S{F.G, F.bid, (const char*)F.XN, (const char*)F.W1T, (const char*)F.MN, (const char*)F.WKVT};
        EpiP1 E{F.PVF, F.PA, F.AB, F.FO, F.Q, F.KV};
        pg8::gemm_phase<EpiP1, SchedP1, true, true>(F.lds, S, E);
    }
    SEAM(1);
    if (IN(2)) { pool_phase(F); dft1_phase(F); attn_phase_mfma(F, (char*)lds_); }
    SEAM(2);
    if (IN(3)) { dft2_phase(F); }
    SEAM(3);
    if (IN(4)) {
        SchedP3 S{F.G, F.bid, (const char*)F.PA, (const char*)F.XN, (const char*)F.FO, (const char*)F.WPOT, (const char*)F.WGT, (const char*)F.WFAT};
        EpiP3 E{F.stash, F.b_gate, F.MERGED};
        pg8::gemm_phase<EpiP3, SchedP3, true, true>(F.lds, S, E);
    }
    SEAM(4);
    if (IN(5)) {
        SchedP4 S{F.G, F.bid, (const char*)F.MERGED, (const char*)F.WOT};
        EpiP4 E{F.xp, F.xs, F.out};
        pg8::gemm_phase<EpiP4, SchedP4, true, true>(F.lds, S, E);
    }
    SEAM(5);
    if (IN(6)) { final_norm_phase(F); }
#undef IN
#undef SEAM
}

extern "C" void kernel_launch(void* const* d_in, const int* in_sizes, int n_in, void* d_out, int out_size, void* d_ws, size_t ws_size, hipStream_t stream) {
    static int grid = 0;
    if (grid == 0) {
        if (n_in != 17 || in_sizes[0] != MP * DM || in_sizes[1] != MS * DM || out_size != MT * DM || ws_size < WS_END) {
            fprintf(stderr, "kernel_launch: unexpected shapes: n_in %d in0 %d in1 %d out %d ws %zu (need %zu); nothing launched\n", n_in, n_in > 0 ? in_sizes[0] : -1, n_in > 1 ? in_sizes[1] : -1, out_size, ws_size, (size_t)WS_END);
            grid = -1; return; }
        int dev = 0, cus = 0, per_cu = 0;
        if (hipGetDevice(&dev) != hipSuccess || hipDeviceGetAttribute(&cus, hipDeviceAttributeMultiprocessorCount, dev) != hipSuccess) { grid = -1; return; }
        if (hipFuncSetAttribute((const void*)fwd, hipFuncAttributeMaxDynamicSharedMemorySize, LDS_BYTES) != hipSuccess) { fprintf(stderr, "kernel_launch: hipFuncSetAttribute failed\n"); grid = -1; return; }
        if (hipOccupancyMaxActiveBlocksPerMultiprocessor(&per_cu, (const void*)fwd, NTHR, LDS_BYTES) != hipSuccess || per_cu < 1) { fprintf(stderr, "kernel_launch: occupancy query says %d\n", per_cu); per_cu = 1; }
        (void)hipGetLastError();
        grid = cus;
        if (grid > 256) grid = 256;
    }
    if (grid < 0) return;
    Args a{};
    for (int i = 0; i < 17; ++i) a.in[i] = (const float*)d_in[i];
    a.out = (float*)d_out; a.ws = (unsigned char*)d_ws;
#if MK_FUSED
    a.ph_lo = 0; a.ph_hi = N_PHASES;
    void* kargs[] = {&a};
    hipError_t e = hipLaunchCooperativeKernel((const void*)fwd, dim3(grid), dim3(NTHR), kargs, LDS_BYTES, stream);
    if (e != hipSuccess) fprintf(stderr, "kernel_launch: cooperative launch failed: %s (grid %d)\n", hipGetErrorString(e), grid);
#else
    for (int p = 0; p < N_PHASES; ++p) {
        a.ph_lo = p; a.ph_hi = p + 1;
        hipLaunchKernelGGL(fwd, dim3(grid), dim3(NTHR), LDS_BYTES, stream, a);
        const hipError_t le = hipPeekAtLastError();
        if (le != hipSuccess) { fprintf(stderr, "kernel_launch: launch %d failed: %s\n", p, hipGetErrorName(le)); break; }
    }
#endif
}
```

```cpp
#include <hip/hip_runtime.h>
#include <hip/hip_cooperative_groups.h>
#include <cstdio>
#include <cstdint>
namespace cg = cooperative_groups;

#ifndef MK_FUSED
#define MK_FUSED 1
#endif

#define LAS __attribute__((address_space(3)))
typedef unsigned short bf16_t;
typedef short bf16x8 __attribute__((ext_vector_type(8)));
typedef float f32x4 __attribute__((ext_vector_type(4)));
typedef float f32x2 __attribute__((ext_vector_type(2)));
typedef unsigned u32x4 __attribute__((ext_vector_type(4)));
typedef unsigned u32x2 __attribute__((ext_vector_type(2)));

constexpr int DM = 1024;
constexpr int MP = 16 * 2048, MS = 16384, MT = MP + MS;
constexpr int NSEQ = 17, NMEM = 256, MMEM = NSEQ * NMEM;
constexpr int INW = 7168;
constexpr float EPS = 1e-6f;
constexpr int NTHR = 512, NWAVES = 8;

constexpr size_t MiB = 1u << 20;
constexpr size_t WS_W1T = 1 * MiB;
constexpr size_t WS_WGT = 10 * MiB;
constexpr size_t WS_WPOT = 16 * MiB, WS_WFAT = 18 * MiB, WS_WOT = 20 * MiB, WS_WKVT = 22 * MiB;
constexpr size_t WS_MN = 24 * MiB;
constexpr size_t WS_KV = 33 * MiB;
constexpr size_t WS_XN = 48 * MiB;
constexpr size_t WS_PA = 144 * MiB;
constexpr size_t WS_FO = 240 * MiB;
constexpr size_t WS_AB = 336 * MiB;
constexpr size_t WS_Q = 432 * MiB;
constexpr size_t WS_END = 480 * MiB;
constexpr size_t OUT_PVF = 0, OUT_Y1 = 96 * MiB, OUT_STASH = 0;

constexpr int RING_BYTES = 131072;
constexpr int TAB_OFF = RING_BYTES + 1024;
constexpr int LDS_BYTES = 147456;

__device__ __forceinline__ unsigned f2bf(float f) { unsigned u = __builtin_bit_cast(unsigned, f); return (u + 0x7fffu + ((u >> 16) & 1u)) >> 16; }
__device__ __forceinline__ unsigned pk2(float lo, float hi) { return f2bf(lo) | (f2bf(hi) << 16); }
__device__ __forceinline__ float bflo(unsigned u) { return __builtin_bit_cast(float, u << 16); }
__device__ __forceinline__ float bfhi(unsigned u) { return __builtin_bit_cast(float, u & 0xffff0000u); }
__device__ __forceinline__ unsigned cvt_pk_bf16(float lo, float hi) { unsigned r; asm volatile("v_cvt_pk_bf16_f32 %0, %1, %2" : "=v"(r) : "v"(lo), "v"(hi)); return r; }
__device__ __forceinline__ float sigmoid_f(float v) { return __builtin_amdgcn_rcpf(1.0f + __expf(-v)); }
__device__ __forceinline__ float silu_f(float v) { return v * sigmoid_f(v); }
__device__ __forceinline__ float wave_sum(float v) {
#pragma unroll
    for (int o = 1; o < 64; o <<= 1) v += __shfl_xor(v, o);
    return v;
}
__device__ __forceinline__ float wave_max(float v) {
#pragma unroll
    for (int o = 1; o < 64; o <<= 1) v = fmaxf(v, __shfl_xor(v, o));
    return v;
}
#define LDS_WAIT() asm volatile("s_waitcnt lgkmcnt(0)" ::: "memory")

namespace pg8 {
constexpr int BM = 256, BK = 64, HALF = 128, HTB = HALF * BK * 2, STAGE_BYTES = 8 * HTB, NXCD = 8, WGM = 8;
constexpr int KP = 1024;
constexpr size_t TSTEP = (size_t)BM * KP * 2;
__device__ __forceinline__ int lds_byte(int r, int c) { const int st = (r >> 4) * 2 + (c >> 5), rr = r & 15, cc = c & 31, ob = rr * 64 + cc * 2; return st * 1024 + (ob ^ (((ob >> 9) & 1) << 5)); }
__device__ __forceinline__ void stage_rc(int b, int& R, int& C) { const int st = b / 1024, sb = b % 1024, swz = sb ^ (((sb >> 9) & 1) << 5); R = (st >> 1) * 16 + swz / 64; C = (st & 1) * 32 + (swz % 64) / 2; }
__device__ __forceinline__ int perm32(int rho) { const int n = rho >> 4, i = rho & 15; return 8 * (i >> 2) + 4 * n + (i & 3); }

struct Unit { const char* A; const char* B; int nt, pm, pn, seg; };

__device__ __forceinline__ void tile_order(int L, int nM, int nN, int& pm, int& pn) {
    const int nwg = nM * nN; int wgid = L;
    { const int q = nwg / NXCD, r = nwg % NXCD, xcd = wgid % NXCD, off = wgid / NXCD; wgid = (xcd < r ? xcd * (q + 1) : r * (q + 1) + (xcd - r) * q) + off; }
    const int nig = WGM * nN, gid = wgid / nig, fm = gid * WGM, gsz = (nM - fm) < WGM ? (nM - fm) : WGM;
    pm = fm + ((wgid % nig) % gsz); pn = (wgid % nig) / gsz;
}

template <class Epi, class Sched, bool ALIGN_EPI, bool SP2>
__device__ __forceinline__ void gemm_phase(LAS unsigned char* lds, const Sched& S, const Epi& E) {
    const int tid = threadIdx.x, wid = __builtin_amdgcn_readfirstlane(tid >> 6), lane = tid & 63, wr = wid >> 2, wc = wid & 3, fr = lane & 15, fq = lane >> 4;
    unsigned voffA[2], voffB[2];
#pragma unroll
    for (int i = 0; i < 2; ++i) { int R, C; stage_rc(tid * 16 + i * 8192, R, C); const int Rb = Epi::PERM ? ((R & ~31) + perm32(R & 31)) : R;
        voffA[i] = (unsigned)(R * KP + C) * 2u; voffB[i] = (unsigned)(Rb * KP + C) * 2u; }
    const size_t kstep = (size_t)(BK * 2);
    const size_t hstep = (size_t)HALF * KP * 2;
    const unsigned ldsw = (unsigned)wid * 1024u;
    const int aoff = lds_byte(wr * 64 + fr, fq * 8), boff = lds_byte(wc * 32 + fr, fq * 8);
#define PG8_SA(b, h) (((b) * 2 + (h)) * HTB)
#define PG8_SB(b, h) ((4 + (b) * 2 + (h)) * HTB)
#define PG8_STAGE(bufoff, gbase, voff) do { _Pragma("unroll") for (int _i = 0; _i < 2; ++_i) \
        __builtin_amdgcn_global_load_lds((const unsigned*)((const char*)(gbase) + (voff)[_i]), (LAS unsigned*)(lds + (bufoff) + ldsw + _i * 8192), 16, 0, 0); } while (0)
#define PG8_LDA(dst, b, h) do { _Pragma("unroll") for (int m = 0; m < 4; ++m) _Pragma("unroll") for (int k = 0; k < 2; ++k) dst[m][k] = *(const LAS bf16x8*)(lds + PG8_SA(b, h) + aoff + m * 2048 + k * 1024); } while (0)
#define PG8_LDB(dst, b, h) do { _Pragma("unroll") for (int n = 0; n < 2; ++n) _Pragma("unroll") for (int k = 0; k < 2; ++k) dst[n][k] = *(const LAS bf16x8*)(lds + PG8_SB(b, h) + boff + n * 2048 + k * 1024); } while (0)
#define PG8_MMA(ai, bj, At, Bt) do { __builtin_amdgcn_s_setprio(1); _Pragma("unroll") for (int m = 0; m < 4; ++m) _Pragma("unroll") for (int n = 0; n < 2; ++n) _Pragma("unroll") for (int k = 0; k < 2; ++k) \
        acc[ai][bj][m][n] = __builtin_amdgcn_mfma_f32_16x16x32_bf16(Bt[n][k], At[m][k], acc[ai][bj][m][n], 0, 0, 0); __builtin_amdgcn_s_setprio(0); } while (0)
#define PG8_WAIT_V(n) asm volatile("s_waitcnt vmcnt(" #n ")" ::: "memory")
#define PG8_WAIT_L(n) asm volatile("s_waitcnt lgkmcnt(" #n ")" ::: "memory")
#define PG8_BAR __builtin_amdgcn_s_barrier()
#define PG8_SCHED __builtin_amdgcn_sched_barrier(0)
    Unit cur, nxt; int ui = 0;
    if (!S.next(0, cur)) return;
    f32x4 acc[2][2][4][2];
#pragma unroll
    for (int a = 0; a < 2; ++a)
#pragma unroll
        for (int b = 0; b < 2; ++b)
#pragma unroll
            for (int m = 0; m < 4; ++m)
#pragma unroll
                for (int n = 0; n < 2; ++n) acc[a][b][m][n] = (f32x4){0.f, 0.f, 0.f, 0.f};
    bf16x8 At[4][2], B0[2][2], B1[2][2];
    const char* cA = cur.A; const char* cB = cur.B;
    if constexpr (SP2) {
        PG8_STAGE(PG8_SB(0, 0), cB, voffB); PG8_STAGE(PG8_SB(0, 1), cB + hstep, voffB); PG8_STAGE(PG8_SA(0, 0), cA, voffA); PG8_STAGE(PG8_SA(0, 1), cA + hstep, voffA);
        if (wr == 1) PG8_BAR;
        PG8_WAIT_V(2); PG8_BAR;
        PG8_STAGE(PG8_SB(1, 0), cB + kstep, voffB); PG8_STAGE(PG8_SA(1, 0), cA + kstep, voffA); PG8_STAGE(PG8_SB(1, 1), cB + hstep + kstep, voffB);
        PG8_WAIT_V(6); PG8_BAR;
    } else {
        PG8_STAGE(PG8_SB(0, 0), cB, voffB); PG8_STAGE(PG8_SA(0, 0), cA, voffA); PG8_STAGE(PG8_SB(0, 1), cB + hstep, voffB); PG8_STAGE(PG8_SA(0, 1), cA + hstep, voffA);
        if (wr == 1) PG8_BAR;
        PG8_WAIT_V(4); PG8_BAR;
        PG8_STAGE(PG8_SB(1, 0), cB + kstep, voffB); PG8_STAGE(PG8_SA(1, 0), cA + kstep, voffA); PG8_STAGE(PG8_SB(1, 1), cB + hstep + kstep, voffB);
        PG8_WAIT_V(6); PG8_BAR;
    }
    for (;;) {
        const bool has_next = S.next(ui + 1, nxt);
        const char* nA = has_next ? nxt.A : cA; const char* nB = has_next ? nxt.B : cB;
        const int nt = cur.nt;
        for (int t = 0; t < nt; t += 2) {
            const bool last = (t == nt - 2);
            const char* a1 = cA + (size_t)(t + 1) * kstep;
            const char* a2 = last ? nA : cA + (size_t)(t + 2) * kstep; const char* b2 = last ? nB : cB + (size_t)(t + 2) * kstep;
            const char* a3 = a2 + kstep; const char* b3 = b2 + kstep;
            if constexpr (SP2) {
            PG8_LDB(B0, 0, 0); PG8_LDB(B1, 0, 1); PG8_SCHED; PG8_LDA(At, 0, 0); PG8_STAGE(PG8_SA(1, 1), a1 + hstep, voffA);
            PG8_WAIT_V(8); PG8_WAIT_L(0); PG8_BAR; PG8_MMA(0, 0, At, B0); PG8_MMA(0, 1, At, B1); PG8_BAR; PG8_SCHED;
            PG8_LDA(At, 0, 1); PG8_STAGE(PG8_SB(0, 0), b2, voffB); PG8_STAGE(PG8_SB(0, 1), b2 + hstep, voffB); PG8_STAGE(PG8_SA(0, 0), a2, voffA);
            PG8_WAIT_V(8); PG8_WAIT_L(0); PG8_BAR; PG8_MMA(1, 0, At, B0); PG8_MMA(1, 1, At, B1); PG8_BAR; PG8_SCHED;
            PG8_LDB(B0, 1, 0); PG8_LDB(B1, 1, 1); PG8_SCHED; PG8_LDA(At, 1, 0); PG8_STAGE(PG8_SA(0, 1), a2 + hstep, voffA);
            PG8_WAIT_V(8); PG8_WAIT_L(0); PG8_BAR; PG8_MMA(0, 0, At, B0); PG8_MMA(0, 1, At, B1); PG8_BAR; PG8_SCHED;
            PG8_LDA(At, 1, 1); PG8_STAGE(PG8_SB(1, 0), b3, voffB); PG8_STAGE(PG8_SB(1, 1), b3 + hstep, voffB); PG8_STAGE(PG8_SA(1, 0), a3, voffA);
            PG8_WAIT_V(8); PG8_WAIT_L(0); PG8_BAR; PG8_MMA(1, 0, At, B0); PG8_MMA(1, 1, At, B1); PG8_BAR; PG8_SCHED;
            } else {
            PG8_LDB(B0, 0, 0); PG8_SCHED; PG8_LDA(At, 0, 0); PG8_STAGE(PG8_SA(1, 1), a1 + hstep, voffA);
            PG8_WAIT_L(8); PG8_BAR; PG8_WAIT_L(0); PG8_MMA(0, 0, At, B0); PG8_BAR; PG8_SCHED;
            PG8_LDB(B1, 0, 1); PG8_STAGE(PG8_SB(0, 0), b2, voffB);
            PG8_BAR; PG8_WAIT_L(0); PG8_MMA(0, 1, At, B1); PG8_BAR;
            PG8_LDA(At, 0, 1); PG8_STAGE(PG8_SA(0, 0), a2, voffA);
            PG8_BAR; PG8_WAIT_L(0); PG8_MMA(1, 0, At, B0); PG8_BAR; PG8_SCHED;
            PG8_STAGE(PG8_SB(0, 1), b2 + hstep, voffB);
            PG8_WAIT_V(6); PG8_BAR; PG8_MMA(1, 1, At, B1); PG8_BAR;
            PG8_LDB(B0, 1, 0); PG8_SCHED; PG8_LDA(At, 1, 0); PG8_STAGE(PG8_SA(0, 1), a2 + hstep, voffA);
            PG8_WAIT_L(8); PG8_BAR; PG8_WAIT_L(0); PG8_MMA(0, 0, At, B0); PG8_BAR; PG8_SCHED;
            PG8_LDB(B1, 1, 1); PG8_STAGE(PG8_SB(1, 0), b3, voffB);
            PG8_BAR; PG8_WAIT_L(0); PG8_MMA(0, 1, At, B1); PG8_BAR;
            PG8_LDA(At, 1, 1); PG8_STAGE(PG8_SA(1, 0), a3, voffA);
            PG8_BAR; PG8_WAIT_L(0); PG8_MMA(1, 0, At, B0); PG8_BAR; PG8_SCHED;
            PG8_STAGE(PG8_SB(1, 1), b3 + hstep, voffB);
            PG8_WAIT_V(6); PG8_BAR; PG8_MMA(1, 1, At, B1); PG8_BAR;
            }
        }
        if constexpr (ALIGN_EPI) { if (wr == 0) PG8_BAR; }
        E(acc, cur, wr, wc, fr, fq);
        if (!has_next) break;
#pragma unroll
        for (int a = 0; a < 2; ++a)
#pragma unroll
            for (int b = 0; b < 2; ++b)
#pragma unroll
                for (int m = 0; m < 4; ++m)
#pragma unroll
                    for (int n = 0; n < 2; ++n) acc[a][b][m][n] = (f32x4){0.f, 0.f, 0.f, 0.f};
        cur = nxt; cA = nA; cB = nB; ++ui;
        if constexpr (ALIGN_EPI) { if (wr == 1) PG8_BAR; }
    }
    PG8_WAIT_V(0);
    if constexpr (!ALIGN_EPI) { if (wr == 0) PG8_BAR; }
    PG8_BAR;
#undef PG8_SA
#undef PG8_SB
#undef PG8_STAGE
#undef PG8_LDA
#undef PG8_LDB
#undef PG8_MMA
#undef PG8_WAIT_V
#undef PG8_WAIT_L
#undef PG8_BAR
#undef PG8_SCHED
}
}
using pg8::Unit;

struct Ctx {
    LAS unsigned char* lds;
    int tid, lane, wave, G, bid;
    const float *xp, *xs, *memp, *mems, *norm_in, *norm_mem, *w_in, *w_pool_grp, *pool_scale, *w_four_grp, *w_kv, *w_pool_out, *w_four_out, *w_attn_out, *b_gate, *w_o, *norm_f;
    float* out;
    bf16_t *W1T, *WGT, *WPOT, *WFAT, *WOT, *WKVT, *MN, *KV, *XN, *PA, *FO, *AB, *Q, *PVF, *Y1, *MERGED, *TAB;
    unsigned char* stash;
};

struct SchedP1 {
    int G, c; const char *XN, *W1T, *MN, *WKVT;
    __device__ __forceinline__ bool next(int i, Unit& u) const {
        int L = i * G + c; u.nt = 16;
        if (L < 192 * 18) { pg8::tile_order(L, 192, 18, u.pm, u.pn); u.A = XN + (size_t)u.pm * pg8::TSTEP; u.B = W1T + (size_t)u.pn * pg8::TSTEP; u.seg = 0; return true; }
        L -= 192 * 18; if (L >= 17 * 4) return false;
        u.pm = L % 17; u.pn = L / 17; u.A = MN + (size_t)u.pm * pg8::TSTEP; u.B = WKVT + (size_t)u.pn * pg8::TSTEP; u.seg = 1; return true;
    }
};
struct EpiP1 {
    static constexpr bool PERM = true;
    bf16_t *PVF, *SPG, *AB, *FO, *Q, *KV;
    __device__ __forceinline__ void operator()(const f32x4 (&acc)[2][2][4][2], const Unit& u, int wr, int wc, int fr, int fq) const {
        bf16_t* base; int ld, colt, act; const int pn = u.pn;
        if (u.seg == 1) { base = KV; ld = 1024; colt = pn * 256; act = 0; }
        else if (pn < 4) { base = PVF; ld = 1024; colt = pn * 256; act = 0; }
        else if (pn < 8) { base = SPG; ld = 1024; colt = (pn - 4) * 256; act = 1; }
        else if (pn < 12) { base = AB; ld = 1024; colt = (pn - 8) * 256; act = 0; }
        else if (pn < 14) { base = FO; ld = 1024; colt = (pn - 12) * 256; act = 1; }
        else if (pn < 16) { base = Q; ld = 512; colt = (pn - 14) * 256; act = 0; }
        else { base = FO; ld = 1024; colt = 512 + (pn - 16) * 256; act = 1; }
        const int row0 = u.pm * 256 + wr * 64 + fr, col0 = colt + wc * 32 + 8 * fq;
#pragma unroll
        for (int ai = 0; ai < 2; ++ai)
#pragma unroll
            for (int m = 0; m < 4; ++m) { bf16_t* rowp = base + (size_t)(row0 + ai * 128 + m * 16) * ld + col0;
#pragma unroll
                for (int bj = 0; bj < 2; ++bj) { f32x4 v0 = acc[ai][bj][m][0], v1 = acc[ai][bj][m][1];
                    if (act) {
#pragma unroll
                        for (int j = 0; j < 4; ++j) { v0[j] = silu_f(v0[j]); v1[j] = silu_f(v1[j]); } }
                    u32x4 w; w.x = cvt_pk_bf16(v0[0], v0[1]); w.y = cvt_pk_bf16(v0[2], v0[3]); w.z = cvt_pk_bf16(v1[0], v1[1]); w.w = cvt_pk_bf16(v1[2], v1[3]);
                    *(u32x4*)(rowp + bj * 128) = w; } }
    }
};
struct SchedP3 {
    int G, c; const char *PA, *XN, *FO, *WPOT, *WGT, *WFAT;
    __device__ __forceinline__ bool next(int i, Unit& u) const {
        const int ti = i / 6, seg = i - 6 * ti, L = ti * G + c; if (L >= 192 * 4) return false;
        pg8::tile_order(L, 192, 4, u.pm, u.pn); u.seg = seg;
        const size_t am = (size_t)u.pm * pg8::TSTEP, bn = (size_t)u.pn * pg8::TSTEP;
        if (seg == 0) { u.A = PA + am; u.B = WPOT + bn; u.nt = 16; }
        else if (seg == 2) { u.A = FO + am; u.B = WFAT + bn; u.nt = 8; }
        else if (seg == 4) { u.A = FO + am + 1024; u.B = WFAT + bn + 1024; u.nt = 8; }
        else { u.A = XN + am; u.B = WGT + (size_t)(4 * (seg >> 1) + u.pn) * pg8::TSTEP; u.nt = 16; }
        return true;
    }
};
struct EpiP3 {
    static constexpr bool PERM = true;
    unsigned char* stash; const float* bgate; bf16_t* MERGED;
    __device__ __forceinline__ void operator()(const f32x4 (&acc)[2][2][4][2], const Unit& u, int wr, int wc, int fr, int fq) const {
        const int tid = threadIdx.x, seg = u.seg;
        const unsigned toff = (unsigned)tid * 16u; const __amdgpu_buffer_rsrc_t srs = __builtin_amdgcn_make_buffer_rsrc((void*)stash, (short)0, 262144, 0x00020000);
        if ((seg & 1) == 0) {
#pragma unroll
            for (int ai = 0; ai < 2; ++ai)
#pragma unroll
                for (int bj = 0; bj < 2; ++bj)
#pragma unroll
                    for (int m = 0; m < 4; ++m) { const f32x4 v0 = acc[ai][bj][m][0], v1 = acc[ai][bj][m][1];
                        u32x4 w; w.x = cvt_pk_bf16(v0[0], v0[1]); w.y = cvt_pk_bf16(v0[2], v0[3]); w.z = cvt_pk_bf16(v1[0], v1[1]); w.w = cvt_pk_bf16(v1[2], v1[3]);
                        __builtin_amdgcn_raw_buffer_store_b128(w, srs, toff, ((ai * 2 + bj) * 4 + m) * 8192, 0); }
        } else {
            const int bcol0 = (seg >> 1) * 1024 + u.pn * 256 + wc * 32 + 8 * fq;
            const int row0 = u.pm * 256 + wr * 64 + fr, col0 = u.pn * 256 + wc * 32 + 8 * fq;
#pragma unroll
            for (int bj = 0; bj < 2; ++bj) {
                const f32x4 b0 = *(const f32x4*)(bgate + bcol0 + bj * 128), b1 = *(const f32x4*)(bgate + bcol0 + bj * 128 + 4);
#pragma unroll
                for (int ai = 0; ai < 2; ++ai)
#pragma unroll
                    for (int m = 0; m < 4; ++m) { const int j = (ai * 2 + bj) * 4 + m;
                        const u32x4 yv = __builtin_amdgcn_raw_buffer_load_b128(srs, toff, j * 8192, 0);
                        const f32x4 a0 = acc[ai][bj][m][0] + b0, a1 = acc[ai][bj][m][1] + b1;
                        float r[8];
                        r[0] = sigmoid_f(a0[0]) * bflo(yv.x); r[1] = sigmoid_f(a0[1]) * bfhi(yv.x); r[2] = sigmoid_f(a0[2]) * bflo(yv.y); r[3] = sigmoid_f(a0[3]) * bfhi(yv.y);
                        r[4] = sigmoid_f(a1[0]) * bflo(yv.z); r[5] = sigmoid_f(a1[1]) * bfhi(yv.z); r[6] = sigmoid_f(a1[2]) * bflo(yv.w); r[7] = sigmoid_f(a1[3]) * bfhi(yv.w);
                        if (seg >= 3) { const u32x4 mv = __builtin_amdgcn_raw_buffer_load_b128(srs, toff, 131072 + j * 8192, 0);
                            r[0] += bflo(mv.x); r[1] += bfhi(mv.x); r[2] += bflo(mv.y); r[3] += bfhi(mv.y); r[4] += bflo(mv.z); r[5] += bfhi(mv.z); r[6] += bflo(mv.w); r[7] += bfhi(mv.w); }
                        u32x4 w; w.x = cvt_pk_bf16(r[0], r[1]); w.y = cvt_pk_bf16(r[2], r[3]); w.z = cvt_pk_bf16(r[4], r[5]); w.w = cvt_pk_bf16(r[6], r[7]);
                        if (seg < 5) __builtin_amdgcn_raw_buffer_store_b128(w, srs, toff, 131072 + j * 8192, 0);
                        else *(u32x4*)(MERGED + (size_t)(row0 + ai * 128 + m * 16) * 1024 + col0 + bj * 128) = w;
                        if (m & 1) asm volatile("" ::: "memory"); }
            }
        }
    }
};
struct SchedP4 {
    int G, c; const char *MERGED, *WOT;
    __device__ __forceinline__ bool next(int i, Unit& u) const {
        const int L = i * G + c; if (L >= 192 * 4) return false;
        pg8::tile_order(L, 192, 4, u.pm, u.pn); u.A = MERGED + (size_t)u.pm * pg8::TSTEP; u.B = WOT + (size_t)u.pn * pg8::TSTEP; u.nt = 16; u.seg = 0; return true;
    }
};
struct EpiP4 {
    static constexpr bool PERM = false;
    const float *xp, *xs; float* out;
    __device__ __forceinline__ void operator()(const f32x4 (&acc)[2][2][4][2], const Unit& u, int wr, int wc, int fr, int fq) const {
        const int row0 = u.pm * 256 + wr * 64 + fr, col0 = u.pn * 256 + wc * 32 + 4 * fq;
        const float* xb = (u.pm < MP / 256) ? xp : xs - (size_t)MP * DM;
#pragma unroll
        for (int ai = 0; ai < 2; ++ai)
#pragma unroll
            for (int m = 0; m < 4; ++m) { const size_t off = (size_t)(row0 + ai * 128 + m * 16) * DM + col0;
#pragma unroll
                for (int bj = 0; bj < 2; ++bj)
#pragma unroll
                    for (int n = 0; n < 2; ++n) { const f32x4 xv = *(const f32x4*)(xb + off + bj * 128 + n * 16); *(f32x4*)(out + off + bj * 128 + n * 16) = xv + acc[ai][bj][m][n]; }
                asm volatile("" ::: "memory"); }
    }
};

__device__ __forceinline__ void transpose_item(const float* W, int ldw, bf16_t* WT, int nblk, LAS float* scr, int item, int lane) {
    const int kb = item / nblk, nb = item % nblk, k0 = 64 * kb, n0 = 32 * nb;
#pragma unroll 8
    for (int i = 0; i < 32; ++i) { const int kk = 2 * i + (lane >> 5); scr[kk * 33 + (lane & 31)] = W[(size_t)(k0 + kk) * ldw + n0 + (lane & 31)]; }
    LDS_WAIT(); asm volatile("" ::: "memory");
    const int c = lane & 7;
#pragma unroll
    for (int j = 0; j < 4; ++j) { const int n = (lane >> 3) + 8 * j; const LAS float* s = scr + (8 * c) * 33 + n;
        u32x4 o; o.x = pk2(s[0 * 33], s[1 * 33]); o.y = pk2(s[2 * 33], s[3 * 33]); o.z = pk2(s[4 * 33], s[5 * 33]); o.w = pk2(s[6 * 33], s[7 * 33]);
        *(u32x4*)(WT + (size_t)(n0 + n) * 1024 + k0 + 8 * c) = o; }
    LDS_WAIT(); asm volatile("" ::: "memory");
}
__device__ __forceinline__ void rms_row_to_bf16(const float* xrow, const float* gain, bf16_t* orow, int lane) {
    const f32x4* xr = (const f32x4*)xrow + lane; const f32x4* gr = (const f32x4*)gain + lane;
    f32x4 v[4]; float s = 0.f;
#pragma unroll
    for (int j = 0; j < 4; ++j) { v[j] = xr[64 * j]; s += (v[j].x * v[j].x + v[j].y * v[j].y) + (v[j].z * v[j].z + v[j].w * v[j].w); }
    const float r = 1.0f / sqrtf(wave_sum(s) * (1.f / DM) + EPS);
    u32x2* o8 = (u32x2*)orow + lane;
#pragma unroll
    for (int j = 0; j < 4; ++j) { const f32x4 g = gr[64 * j]; u32x2 w; w.x = pk2(v[j].x * r * g.x, v[j].y * r * g.y); w.y = pk2(v[j].z * r * g.z, v[j].w * r * g.w); o8[64 * j] = w; }
}
__device__ __forceinline__ void fold_item(const Ctx& F, int item) {
    LAS float* As = (LAS float*)F.lds;
    LAS float* Bs = (LAS float*)(F.lds + 16384);
    LAS float* Ts = (LAS float*)(F.lds + 32768);
    const LAS f32x2* tab = (const LAS f32x2*)(F.lds + TAB_OFF);
    const int tid = F.tid, tk = tid & 63, tj = tid >> 6;
    float acc[8];
#pragma unroll
    for (int j = 0; j < 8; ++j) acc[j] = 0.f;
    if (item < 256) {
        const int g = item >> 6, k0 = ((item >> 2) & 15) * 64, j0 = (item & 3) * 64;
        for (int c0 = 0; c0 < 256; c0 += 32) {
            __syncthreads();
#pragma unroll
            for (int i = 0; i < 4; ++i) { const int idx = tid + 512 * i; { const int kk = idx >> 5, cc = idx & 31; As[kk * 33 + cc] = F.w_in[(size_t)(k0 + kk) * INW + g * 256 + c0 + cc]; }
                { const int cc = idx >> 6, jj = idx & 63; Bs[cc * 64 + jj] = F.w_pool_grp[(size_t)(g * 256 + c0 + cc) * 256 + j0 + jj]; } }
            __syncthreads();
#pragma unroll 8
            for (int cc = 0; cc < 32; ++cc) { const float a = As[tk * 33 + cc];
#pragma unroll
                for (int j = 0; j < 8; ++j) acc[j] += a * Bs[cc * 64 + tj * 8 + j]; }
        }
#pragma unroll
        for (int j = 0; j < 8; ++j) { const int n = g * 256 + j0 + tj * 8 + j; F.W1T[(size_t)n * 1024 + k0 + tk] = (bf16_t)f2bf(acc[j] * F.pool_scale[n]); }
    } else {
        const int it = item - 256, g = it >> 6, sn = (it >> 5) & 1, k0 = ((it >> 1) & 15) * 64, j0 = (it & 1) * 64;
        __syncthreads();
        { const int c = tid & 127, jq = tid >> 7; float t[16];
#pragma unroll
            for (int j = 0; j < 16; ++j) t[j] = 0.f;
            for (int d = 0; d < 128; ++d) { const f32x2 cs = tab[(c * d) & 127]; const float w = sn ? cs.y : cs.x;
                const f32x4* wp = (const f32x4*)(F.w_four_grp + (size_t)(g * 128 + d) * 128 + j0 + jq * 16);
#pragma unroll
                for (int q = 0; q < 4; ++q) { const f32x4 x = wp[q]; t[4 * q] += w * x.x; t[4 * q + 1] += w * x.y; t[4 * q + 2] += w * x.z; t[4 * q + 3] += w * x.w; } }
#pragma unroll
            for (int j = 0; j < 16; ++j) Ts[c * 64 + jq * 16 + j] = t[j] * 0.08838834764831845f; }
        for (int c0 = 0; c0 < 128; c0 += 32) {
            __syncthreads();
#pragma unroll
            for (int i = 0; i < 4; ++i) { const int idx = tid + 512 * i; const int kk = idx >> 5, cc = idx & 31; As[kk * 33 + cc] = F.w_in[(size_t)(k0 + kk) * INW + 2048 + g * 128 + c0 + cc]; }
            __syncthreads();
#pragma unroll 8
            for (int cc = 0; cc < 32; ++cc) { const float a = As[tk * 33 + cc];
#pragma unroll
                for (int j = 0; j < 8; ++j) acc[j] += a * Ts[(c0 + cc) * 64 + tj * 8 + j]; }
        }
#pragma unroll
        for (int j = 0; j < 8; ++j) { const int n = 2048 + sn * 512 + g * 128 + j0 + tj * 8 + j; F.W1T[(size_t)n * 1024 + k0 + tk] = (bf16_t)f2bf(acc[j]); }
    }
    __syncthreads();
}
__device__ __forceinline__ void build_tables(const Ctx& F, bf16_t* T);
__device__ __forceinline__ void p0_prologue(const Ctx& F) {
    build_tables(F, F.TAB);
    for (int it = F.bid; it < 512; it += F.G) fold_item(F, it);
    __syncthreads();
    LAS float* scr = (LAS float*)(F.lds + F.wave * 16384);
    const int gw = F.bid * NWAVES + F.wave, NGW = F.G * NWAVES;
    constexpr int I0 = 16 * 32, I1 = 16 * 16, I4 = 16 * 96, I5 = 16 * 32, I6 = 8 * 32;
    constexpr int NITEMS = I0 + 3 * I1 + I4 + I5 + 2 * I6 + 2 * I5;
    for (int it = gw; it < NITEMS; it += NGW) {
        int r = it;
        if (r < I0) { transpose_item(F.w_in + 1024, INW, F.W1T + (size_t)1024 * 1024, 32, scr, r, F.lane); continue; } r -= I0;
        if (r < I1) { transpose_item(F.w_in + 2560, INW, F.W1T + (size_t)3072 * 1024, 16, scr, r, F.lane); continue; } r -= I1;
        if (r < I1) { transpose_item(F.w_in + 3072, INW, F.W1T + (size_t)3584 * 1024, 16, scr, r, F.lane); continue; } r -= I1;
        if (r < I1) { transpose_item(F.w_in + 3584, INW, F.W1T + (size_t)4096 * 1024, 16, scr, r, F.lane); continue; } r -= I1;
        if (r < I4) { transpose_item(F.w_in + 4096, INW, F.WGT, 96, scr, r, F.lane); continue; } r -= I4;
        if (r < I5) { transpose_item(F.w_pool_out, 1024, F.WPOT, 32, scr, r, F.lane); continue; } r -= I5;
        if (r < I6) { transpose_item(F.w_four_out, 1024, F.WFAT, 32, scr, r, F.lane); continue; } r -= I6;
        if (r < I6) { transpose_item(F.w_attn_out, 1024, F.WFAT + 512, 32, scr, r, F.lane); continue; } r -= I6;
        if (r < I5) { transpose_item(F.w_o, 1024, F.WOT, 32, scr, r, F.lane); continue; } r -= I5;
        transpose_item(F.w_kv, 1024, F.WKVT, 32, scr, r, F.lane);
    }
    for (int m = gw; m < MT + MMEM; m += NGW) {
        if (m < MP) rms_row_to_bf16(F.xp + (size_t)m * DM, F.norm_in, F.XN + (size_t)m * DM, F.lane);
        else if (m < MT) rms_row_to_bf16(F.xs + (size_t)(m - MP) * DM, F.norm_in, F.XN + (size_t)m * DM, F.lane);
        else { const int r = m - MT; const float* src = r < 16 * NMEM ? F.memp + (size_t)r * DM : F.mems + (size_t)(r - 16 * NMEM) * DM; rms_row_to_bf16(src, F.norm_mem, F.MN + (size_t)r * DM, F.lane); }
    }
}

__device__ __forceinline__ void seq_of_row(int row, int& r0, int& S) { if (row < MP) { r0 = row & ~2047; S = 2048; } else { r0 = MP; S = MS; } }
__device__ __forceinline__ void pool_phase(const Ctx& F) {
    const long total = (long)MT * 128;
    for (long it = (long)F.bid * NTHR + F.tid; it < total; it += (long)F.G * NTHR) {
        const int row = (int)(it >> 7), ch = (int)(it & 127), col = ch * 8, g = ch >> 5, half = 1 << g;
        int r0, S; seq_of_row(row, r0, S);
        const int t = row - r0, lo = t - half < 0 ? 0 : t - half, hi = t + half > S ? S : t + half;
        float s[8];
#pragma unroll
        for (int j = 0; j < 8; ++j) s[j] = 0.f;
        for (int i = lo; i < hi; ++i) { const u32x4 v = *(const u32x4*)(F.PVF + (size_t)(r0 + i) * 1024 + col);
            s[0] += bflo(v.x); s[1] += bfhi(v.x); s[2] += bflo(v.y); s[3] += bfhi(v.y); s[4] += bflo(v.z); s[5] += bfhi(v.z); s[6] += bflo(v.w); s[7] += bfhi(v.w); }
        const float inv = 1.0f / (float)(hi - lo);
        const u32x4 me = *(const u32x4*)(F.PVF + (size_t)row * 1024 + col); const u32x4 gt = *(const u32x4*)(F.PA + (size_t)row * 1024 + col);
        u32x4 o;
        o.x = pk2((s[0] * inv - bflo(me.x)) * bflo(gt.x), (s[1] * inv - bfhi(me.x)) * bfhi(gt.x));
        o.y = pk2((s[2] * inv - bflo(me.y)) * bflo(gt.y), (s[3] * inv - bfhi(me.y)) * bfhi(gt.y));
        o.z = pk2((s[4] * inv - bflo(me.z)) * bflo(gt.z), (s[5] * inv - bfhi(me.z)) * bfhi(gt.z));
        o.w = pk2((s[6] * inv - bflo(me.w)) * bflo(gt.w), (s[7] * inv - bfhi(me.w)) * bfhi(gt.w));
        *(u32x4*)(F.PA + (size_t)row * 1024 + col) = o;
    }
}
__device__ __forceinline__ void dft1_phase(const Ctx& F) {
    const LAS f32x2* tab = (const LAS f32x2*)(F.lds + TAB_OFF);
    for (int it = F.bid; it < 16384 + 8192; it += F.G) {
        int seq, s2, head, chk, N1, r0, S, sh;
        if (it < 16384) { seq = it >> 10; const int r = it & 1023; s2 = r >> 3; head = (r >> 1) & 3; chk = r & 1; N1 = 16; r0 = seq * 2048; S = 2048; sh = 3; }
        else { const int r = it - 16384; seq = 16; s2 = r >> 6; head = (r >> 4) & 3; chk = r & 15; N1 = 128; r0 = MP; S = MS; sh = 0; }
        const int k1 = chk * 8 + (F.tid >> 6), col = head * 128 + 2 * (F.tid & 63);
        float yr0 = 0.f, yr1 = 0.f, yi0 = 0.f, yi1 = 0.f;
        for (int s1 = 0; s1 < N1; ++s1) {
            const size_t ro = (size_t)(r0 + 128 * s1 + s2) * 1024 + col;
            const unsigned av = *(const unsigned*)(F.AB + ro), bv = *(const unsigned*)(F.AB + ro + 512);
            const f32x2 cs = tab[((k1 * s1) << sh) & 127];
            const float a0 = bflo(av), a1 = bfhi(av), b0 = bflo(bv), b1 = bfhi(bv);
            yr0 += cs.x * a0 - cs.y * b0; yi0 += cs.y * a0 + cs.x * b0;
            yr1 += cs.x * a1 - cs.y * b1; yi1 += cs.y * a1 + cs.x * b1;
        }
        float tc, ts; { const float ang = 2.0f * (float)(k1 * s2) / (float)S; ts = sinpif(ang); tc = cospif(ang); }
        const float sc = N1 == 16 ? 0.25f : 0.08838834764831845f; tc *= sc; ts *= sc;
        const size_t wo = (size_t)(r0 + 128 * k1 + s2) * 1024 + col;
        *(unsigned*)(F.Y1 + wo) = pk2(yr0 * tc - yi0 * ts, yr1 * tc - yi1 * ts);
        *(unsigned*)(F.Y1 + wo + 512) = pk2(yr0 * ts + yi0 * tc, yr1 * ts + yi1 * tc);
    }
}
__device__ __forceinline__ void dft2_phase(const Ctx& F) {
    const LAS f32x2* tab = (const LAS f32x2*)(F.lds + TAB_OFF);
    for (int it = F.bid; it < 16384 + 8192; it += F.G) {
        int seq, k1, head, chk, N1, r0;
        if (it < 16384) { seq = it >> 10; const int r = it & 1023; k1 = r >> 6; head = (r >> 4) & 3; chk = r & 15; N1 = 16; r0 = seq * 2048; }
        else { const int r = it - 16384; seq = 16; k1 = r >> 6; head = (r >> 4) & 3; chk = r & 15; N1 = 128; r0 = MP; }
        const int k2 = chk * 8 + (F.tid >> 6), col = head * 128 + 2 * (F.tid & 63);
        float f0 = 0.f, f1 = 0.f;
        for (int s2 = 0; s2 < 128; ++s2) {
            const size_t ro = (size_t)(r0 + 128 * k1 + s2) * 1024 + col;
            const unsigned rv = *(const unsigned*)(F.Y1 + ro), iv = *(const unsigned*)(F.Y1 + ro + 512);
            const f32x2 cs = tab[(k2 * s2) & 127];
            f0 += cs.x * bflo(rv) - cs.y * bflo(iv); f1 += cs.x * bfhi(rv) - cs.y * bfhi(iv);
        }
        const size_t wo = (size_t)(r0 + k1 + N1 * k2) * 1024 + col;
        const unsigned gt = *(const unsigned*)(F.FO + wo);
        *(unsigned*)(F.FO + wo) = pk2(f0 * 0.08838834764831845f * bflo(gt), f1 * 0.08838834764831845f * bfhi(gt));
    }
}

namespace dft {
using s16x4 = __attribute__((ext_vector_type(4))) short;
constexpr int ROWB = 288;
template <int OFF> __device__ __forceinline__ s16x4 tr(unsigned a) { s16x4 r; asm volatile("ds_read_b64_tr_b16 %0, %1 offset:%2" : "=&v"(r) : "v"(a), "i"(OFF) : "memory"); return r; }
__device__ __forceinline__ bf16x8 efrag(const bf16_t* E, int ldE, int row, int ks, int G) {
    const bf16_t* p = E + (size_t)row * ldE + 32 * ks + 16 * (G >> 1) + 4 * (G & 1);
    const u32x2 a = *(const u32x2*)p, b = *(const u32x2*)(p + 8);
    u32x4 w; w.x = a.x; w.y = a.y; w.z = b.x; w.w = b.y; return __builtin_bit_cast(bf16x8, w);
}
template <int MT, int KS>
__device__ __forceinline__ void mma(f32x4 (&acc)[MT][8], const bf16x8 (&ef)[MT][KS], unsigned vbase) {
#pragma unroll
    for (int ks = 0; ks < KS; ++ks) {
        const unsigned b = vbase + ks * (32 * ROWB);
        s16x4 lo[8], hi[8];
        lo[0] = tr<0>(b);   hi[0] = tr<8 * ROWB + 0>(b);   lo[1] = tr<32>(b);  hi[1] = tr<8 * ROWB + 32>(b);  lo[2] = tr<64>(b);  hi[2] = tr<8 * ROWB + 64>(b);  lo[3] = tr<96>(b);  hi[3] = tr<8 * ROWB + 96>(b);
        lo[4] = tr<128>(b); hi[4] = tr<8 * ROWB + 128>(b); lo[5] = tr<160>(b); hi[5] = tr<8 * ROWB + 160>(b); lo[6] = tr<192>(b); hi[6] = tr<8 * ROWB + 192>(b); lo[7] = tr<224>(b); hi[7] = tr<8 * ROWB + 224>(b);
        asm volatile("s_waitcnt lgkmcnt(0)" ::: "memory"); __builtin_amdgcn_sched_barrier(0);
#pragma unroll
        for (int nt = 0; nt < 8; ++nt) { const bf16x8 vf = (bf16x8){lo[nt][0], lo[nt][1], lo[nt][2], lo[nt][3], hi[nt][0], hi[nt][1], hi[nt][2], hi[nt][3]};
#pragma unroll
            for (int mt = 0; mt < MT; ++mt) acc[mt][nt] = __builtin_amdgcn_mfma_f32_16x16x32_bf16(vf, ef[mt][ks], acc[mt][nt], 0, 0, 0); }
    }
}
struct Stage { u32x4 v[8]; };
template <int MODE> __device__ __forceinline__ void load(Stage& st, const bf16_t* buf, int r0, int x, int h, int tid) {
#pragma unroll
    for (int i = 0; i < 8; ++i) { const int c = tid + 512 * i, kr = c >> 4, c16 = c & 15; int row, part;
        if (MODE == 0) { row = r0 + 128 * (kr & 127) + x; part = kr >> 7; }
        else if (MODE == 1) { const int kk = kr & 31; row = r0 + 128 * (kk & 15) + x + (kr >> 5); part = kk >> 4; }
        else { row = r0 + 128 * x + (kr & 127); part = kr >> 7; }
        st.v[i] = *(const u32x4*)(buf + (size_t)row * 1024 + part * 512 + h * 128 + c16 * 8); }
}
__device__ __forceinline__ void store_image(const Stage& st, LAS unsigned char* img, int tid) {
#pragma unroll
    for (int i = 0; i < 8; ++i) { const int c = tid + 512 * i; *(LAS u32x4*)(img + (c >> 4) * ROWB + (c & 15) * 16) = st.v[i]; }
}
}
template <int N1>
__device__ __forceinline__ void dft1_mfma(const Ctx& F, const bf16_t* E) {
    constexpr int KS = N1 == 128 ? 8 : 1, MODE = N1 == 128 ? 0 : 1, LDE = 2 * N1;
    const int lane = F.lane, G = lane >> 4, i16 = lane & 15, w = F.wave;
    const int nitems = N1 == 128 ? 128 * 4 : 16 * 16 * 4;
    LAS unsigned char* img = F.lds;
    const unsigned vbase = (unsigned)(uintptr_t)img + (16 * (G >> 1) + 4 * (G & 1) + (i16 >> 2)) * dft::ROWB + 8 * (lane & 3) + (N1 == 128 ? 0 : w * 32 * dft::ROWB);
    const int k1 = (N1 == 128 ? 16 * w : 0) + i16;
    bf16x8 ef[2][KS];
#pragma unroll
    for (int ks = 0; ks < KS; ++ks) { ef[0][ks] = dft::efrag(E, LDE, k1, ks, G); ef[1][ks] = dft::efrag(E, LDE, N1 + k1, ks, G); }
    dft::Stage st;
    int it = F.bid;
    auto decode = [&](int item, int& r0, int& x, int& h) { if (N1 == 128) { r0 = MP; x = item >> 2; h = item & 3; } else { r0 = (item >> 6) * 2048; x = ((item >> 2) & 15) * 8; h = item & 3; } };
    int r0, x, h;
    if (it < nitems) { decode(it, r0, x, h); dft::load<MODE>(st, F.AB, r0, x, h, F.tid); }
    for (; it < nitems; it += F.G) {
        decode(it, r0, x, h);
        __syncthreads();
        dft::store_image(st, img, F.tid);
        __syncthreads();
        { const int nx = it + F.G; if (nx < nitems) { int r0n, xn, hn; decode(nx, r0n, xn, hn); dft::load<MODE>(st, F.AB, r0n, xn, hn, F.tid); } }
        f32x4 acc[2][8];
#pragma unroll
        for (int a = 0; a < 2; ++a)
#pragma unroll
            for (int n = 0; n < 8; ++n) acc[a][n] = (f32x4){0.f, 0.f, 0.f, 0.f};
        dft::mma<2, KS>(acc, ef, vbase);
        const int s2 = N1 == 128 ? x : x + w, S = N1 == 128 ? MS : 2048;
        const float ang = 2.0f * (float)(k1 * s2) / (float)S; const float ts = sinpif(ang), tc = cospif(ang);
        bf16_t* orow = F.AB + (size_t)(r0 + 128 * k1 + s2) * 1024 + h * 128 + 4 * G;
#pragma unroll
        for (int nt = 0; nt < 8; ++nt) { const f32x4 yr = acc[0][nt], yi = acc[1][nt];
            u32x2 re, im;
            re.x = cvt_pk_bf16(yr[0] * tc - yi[0] * ts, yr[1] * tc - yi[1] * ts); re.y = cvt_pk_bf16(yr[2] * tc - yi[2] * ts, yr[3] * tc - yi[3] * ts);
            im.x = cvt_pk_bf16(yr[0] * ts + yi[0] * tc, yr[1] * ts + yi[1] * tc); im.y = cvt_pk_bf16(yr[2] * ts + yi[2] * tc, yr[3] * ts + yi[3] * tc);
            *(u32x2*)(orow + 16 * nt) = re; *(u32x2*)(orow + 512 + 16 * nt) = im; }
    }
    __syncthreads();
}
__device__ __forceinline__ void dft2_mfma(const Ctx& F, const bf16_t* E) {
    const int lane = F.lane, G = lane >> 4, i16 = lane & 15, w = F.wave;
    constexpr int nitems = 16 * 16 * 4 + 128 * 4;
    LAS unsigned char* img = F.lds;
    const unsigned vbase = (unsigned)(uintptr_t)img + (16 * (G >> 1) + 4 * (G & 1) + (i16 >> 2)) * dft::ROWB + 8 * (lane & 3);
    const int k2 = 16 * w + i16;
    bf16x8 ef[1][8];
#pragma unroll
    for (int ks = 0; ks < 8; ++ks) ef[0][ks] = dft::efrag(E, 256, k2, ks, G);
    dft::Stage st;
    int it = F.bid;
    auto decode = [&](int item, int& r0, int& x, int& h, int& N1) { if (item < 1024) { r0 = (item >> 6) * 2048; x = (item >> 2) & 15; h = item & 3; N1 = 16; } else { const int j = item - 1024; r0 = MP; x = j >> 2; h = j & 3; N1 = 128; } };
    int r0, x, h, N1;
    if (it < nitems) { decode(it, r0, x, h, N1); dft::load<2>(st, F.AB, r0, x, h, F.tid); }
    for (; it < nitems; it += F.G) {
        decode(it, r0, x, h, N1);
        __syncthreads();
        dft::store_image(st, img, F.tid);
        __syncthreads();
        { const int nx = it + F.G; if (nx < nitems) { int r0n, xn, hn, nn; decode(nx, r0n, xn, hn, nn); dft::load<2>(st, F.AB, r0n, xn, hn, F.tid); } }
        f32x4 acc[1][8];
#pragma unroll
        for (int n = 0; n < 8; ++n) acc[0][n] = (f32x4){0.f, 0.f, 0.f, 0.f};
        dft::mma<1, 8>(acc, ef, vbase);
        bf16_t* orow = F.FO + (size_t)(r0 + x + N1 * k2) * 1024 + h * 128 + 4 * G;
#pragma unroll
        for (int nt = 0; nt < 8; ++nt) { const f32x4 f = acc[0][nt]; const u32x2 g = *(const u32x2*)(orow + 16 * nt);
            u32x2 o; o.x = cvt_pk_bf16(f[0] * bflo(g.x), f[1] * bfhi(g.x)); o.y = cvt_pk_bf16(f[2] * bflo(g.y), f[3] * bfhi(g.y));
            *(u32x2*)(orow + 16 * nt) = o; }
    }
    __syncthreads();
}
constexpr size_t WS_TAB = 42 * MiB; constexpr int TAB_E116 = 65536, TAB_E2 = 65536 + 1024, TAB_N = 65536 + 1024 + 32768;
__device__ __forceinline__ void build_tables(const Ctx& F, bf16_t* T) {
    for (int idx = F.bid * NTHR + F.tid; idx < TAB_N; idx += F.G * NTHR) {
        float v;
        if (idx < TAB_E116) { const int m = idx >> 8, k = idx & 255, ri = m >> 7, k1 = m & 127, rp = k >> 7, s1 = k & 127; const float a = (float)((k1 * s1) & 127) * (1.0f / 64.0f), c = cospif(a), sn = sinpif(a);
            v = (ri == rp ? c : (ri == 0 ? -sn : sn)) * 0.08838834764831845f; }
        else if (idx < TAB_E2) { const int j = idx - TAB_E116, m = j >> 5, k = j & 31, ri = m >> 4, k1 = m & 15, rp = k >> 4, s1 = k & 15; const float a = (float)((k1 * s1) & 15) * (1.0f / 8.0f), c = cospif(a), sn = sinpif(a);
            v = (ri == rp ? c : (ri == 0 ? -sn : sn)) * 0.25f; }
        else { const int j = idx - TAB_E2, m = j >> 8, k = j & 255, rp = k >> 7, s2 = k & 127; const float a = (float)((m * s2) & 127) * (1.0f / 64.0f);
            v = (rp == 0 ? cospif(a) : -sinpif(a)) * 0.08838834764831845f; }
        T[idx] = (bf16_t)f2bf(v);
    }
}
__device__ __forceinline__ void attn_phase_simple(const Ctx& F) {
    const int gw = F.bid * NWAVES + F.wave, NGW = F.G * NWAVES, lane = F.lane;
    for (int it = gw; it < MT * 4; it += NGW) {
        const int row = it >> 2, h = it & 3, seq = row < MP ? row >> 11 : 16;
        const bf16_t* q = F.Q + (size_t)row * 512 + h * 128;
        const bf16_t* Kb = F.KV + (size_t)(seq * NMEM) * 1024 + h * 128;
        const bf16_t* Vb = Kb + 512;
        float s[4] = {0.f, 0.f, 0.f, 0.f};
        for (int d = 0; d < 128; d += 8) {
            const u32x4 qv = *(const u32x4*)(q + d);
            const float q0 = bflo(qv.x), q1 = bfhi(qv.x), q2 = bflo(qv.y), q3 = bfhi(qv.y), q4 = bflo(qv.z), q5 = bfhi(qv.z), q6 = bflo(qv.w), q7 = bfhi(qv.w);
#pragma unroll
            for (int i = 0; i < 4; ++i) { const u32x4 kv = *(const u32x4*)(Kb + (size_t)(lane + 64 * i) * 1024 + d);
                s[i] += q0 * bflo(kv.x) + q1 * bfhi(kv.x) + q2 * bflo(kv.y) + q3 * bfhi(kv.y) + q4 * bflo(kv.z) + q5 * bfhi(kv.z) + q6 * bflo(kv.w) + q7 * bfhi(kv.w); }
        }
        const float scale = 0.08838834764831845f;
#pragma unroll
        for (int i = 0; i < 4; ++i) s[i] *= scale;
        const float mx = wave_max(fmaxf(fmaxf(s[0], s[1]), fmaxf(s[2], s[3])));
        float p[4], l = 0.f;
#pragma unroll
        for (int i = 0; i < 4; ++i) { p[i] = __expf(s[i] - mx); l += p[i]; }
        l = wave_sum(l);
        float o0 = 0.f, o1 = 0.f;
#pragma unroll
        for (int i = 0; i < 4; ++i)
            for (int kk = 0; kk < 64; ++kk) { const float pk = __shfl(p[i], kk); const unsigned vv = *(const unsigned*)(Vb + (size_t)(64 * i + kk) * 1024 + 2 * lane); o0 += pk * bflo(vv); o1 += pk * bfhi(vv); }
        const float rl = 1.0f / l;
        unsigned* dst = (unsigned*)(F.FO + (size_t)row * 1024 + 512 + h * 128 + 2 * lane);
        const unsigned gt = *dst;
        *dst = pk2(o0 * rl * bflo(gt), o1 * rl * bfhi(gt));
    }
}

namespace att {
using bf16 = unsigned short;
using s16x4  = __attribute__((ext_vector_type(4))) short;
using f32x16 = __attribute__((ext_vector_type(16))) float;
constexpr int D = 128, NW = 8, QBLK = 32, KVBLK = 64;
constexpr float SCALE = 0.088388347648318440f;
constexpr float THR = 8.f;
constexpr int SDEPTH = 2;
constexpr int LDQ = 512, LDK = 1024, LDO = 1024;
constexpr size_t SHM_V = KVBLK * D * 2, SHM_K = KVBLK * D * 2, SHM_ATTN = 2 * SHM_V + 2 * SHM_K + NW * 64 * 4;
#define KSWZ(row, colB) ((row) * 256 + ((colB) ^ (((row) & 7) << 4)))
#define SBAR() __builtin_amdgcn_sched_barrier(0)
__device__ __forceinline__ int crow(int r, int hi) { return (r & 3) + 8 * (r >> 2) + 4 * hi; }
__device__ __forceinline__ unsigned cvtpk(float lo, float hi) { unsigned r; asm volatile("v_cvt_pk_bf16_f32 %0, %1, %2" : "=v"(r) : "v"(lo), "v"(hi)); return r; }
__device__ __forceinline__ bf16x8 ld8(const bf16* p) { return *reinterpret_cast<const bf16x8*>(p); }
__device__ __forceinline__ void partialSM(f32x16& p0, f32x16& p1, float& m_reg, float& mn, float& alpha) {
  constexpr float C = SCALE * 1.4426950408889634f;
  float pmax = p0[0]; for (int r = 1; r < 16; ++r) pmax = fmaxf(pmax, p0[r]); for (int r = 0; r < 16; ++r) pmax = fmaxf(pmax, p1[r]);
  { auto rr = __builtin_amdgcn_permlane32_swap(__float_as_uint(pmax), __float_as_uint(pmax), false, false);
    pmax = fmaxf(__uint_as_float(rr[0]), __uint_as_float(rr[1])); }
  if (__builtin_expect(__all(pmax - m_reg <= THR / SCALE), 1)) { mn = m_reg; alpha = 1.f; }
  else { mn = fmaxf(m_reg, pmax); alpha = __builtin_amdgcn_exp2f((m_reg - mn) * C); m_reg = mn; }
  float mnC = -mn * C;
  for (int r = 0; r < 16; ++r) p0[r] = fmaf(p0[r], C, mnC); for (int r = 0; r < 16; ++r) p1[r] = fmaf(p1[r], C, mnC);
  for (int r = 0; r < 16; ++r) p0[r] = __builtin_amdgcn_exp2f(p0[r]);
}
__device__ __forceinline__ void finishSM(f32x16& p0, f32x16& p1, float alpha, float& l_reg, bf16x8& pa0, bf16x8& pa1, bf16x8& pa2, bf16x8& pa3) {
  for (int r = 0; r < 16; ++r) p1[r] = __builtin_amdgcn_exp2f(p1[r]);
  float ps = 0; for (int r = 0; r < 16; ++r) ps += p0[r]; for (int r = 0; r < 16; ++r) ps += p1[r];
  { auto rr = __builtin_amdgcn_permlane32_swap(__float_as_uint(ps), __float_as_uint(ps), false, false);
    ps = __uint_as_float(rr[0]) + __uint_as_float(rr[1]); }
  l_reg = l_reg * alpha + ps;
#define PK4(P, BASE, OUT) do { unsigned a0 = cvtpk(P[BASE + 0], P[BASE + 1]), a1 = cvtpk(P[BASE + 2], P[BASE + 3]);   \
    unsigned b0 = cvtpk(P[BASE + 4], P[BASE + 5]), b1 = cvtpk(P[BASE + 6], P[BASE + 7]);                              \
    auto r0 = __builtin_amdgcn_permlane32_swap(a0, b0, false, false); auto r1 = __builtin_amdgcn_permlane32_swap(a1, b1, false, false); \
    u32x4 w = {r0[0], r1[0], r0[1], r1[1]}; OUT = *reinterpret_cast<bf16x8*>(&w); } while (0)
  PK4(p0, 0, pa0); PK4(p0, 8, pa1); PK4(p1, 0, pa2); PK4(p1, 8, pa3);
#undef PK4
}
__device__ __forceinline__ void qkt(f32x16& p0, f32x16& p1, const bf16* Ks, const bf16x8* qr, int r32, int hi) {
  p0 = f32x16{}; p1 = f32x16{};
  for (int d0 = 0; d0 < 8; ++d0) { int cb = (d0 * 16 + hi * 8) * 2;
    bf16x8 b0 = *reinterpret_cast<const bf16x8*>((const char*)Ks + KSWZ(r32, cb));
    bf16x8 b1 = *reinterpret_cast<const bf16x8*>((const char*)Ks + KSWZ(32 + r32, cb));
    p0 = __builtin_amdgcn_mfma_f32_32x32x16_bf16(b0, qr[d0], p0, 0, 0, 0);
    p1 = __builtin_amdgcn_mfma_f32_32x32x16_bf16(b1, qr[d0], p1, 0, 0, 0); }
}
__device__ __forceinline__ int v_st(int k, int c) { const int kk = (k & ~0xC) | ((k & 4) << 1) | ((k & 8) >> 1); return ((kk >> 3) * 4 + (c >> 5)) * 512 + ((kk & 7) * 32 + (c & 31)) * 2; }
__device__ __forceinline__ int v_rd_base(int lane) { return ((lane & 3) << 3) | (((lane >> 2) & 3) << 6) | (((lane >> 4) & 1) << 5) | (((lane >> 5) & 1) << 8); }
constexpr int v_rd_off(int d0, int ks, int half) { return d0 * 512 + ks * 4096 + half * 2048; }
template <int OFF> __device__ __forceinline__ s16x4 tr_read(int vb) {
  s16x4 r; asm volatile("ds_read_b64_tr_b16 %0, %1 offset:%2" : "=&v"(r) : "v"(vb), "i"(OFF) : "memory"); return r;
}
template <int D0> __device__ __forceinline__ void pv_one(f32x16& od, int vb, bf16x8 pa0, bf16x8 pa1, bf16x8 pa2, bf16x8 pa3) {
  const s16x4 l0 = tr_read<v_rd_off(D0, 0, 0)>(vb), h0 = tr_read<v_rd_off(D0, 0, 1)>(vb), l1 = tr_read<v_rd_off(D0, 1, 0)>(vb), h1 = tr_read<v_rd_off(D0, 1, 1)>(vb);
  const s16x4 l2 = tr_read<v_rd_off(D0, 2, 0)>(vb), h2 = tr_read<v_rd_off(D0, 2, 1)>(vb), l3 = tr_read<v_rd_off(D0, 3, 0)>(vb), h3 = tr_read<v_rd_off(D0, 3, 1)>(vb);
  asm volatile("s_waitcnt lgkmcnt(0)" ::: "memory"); SBAR();
#define PK(L, H) (bf16x8){L[0], L[1], L[2], L[3], H[0], H[1], H[2], H[3]}
  od = __builtin_amdgcn_mfma_f32_32x32x16_bf16(pa0, PK(l0, h0), od, 0, 0, 0);
  od = __builtin_amdgcn_mfma_f32_32x32x16_bf16(pa1, PK(l1, h1), od, 0, 0, 0);
  od = __builtin_amdgcn_mfma_f32_32x32x16_bf16(pa2, PK(l2, h2), od, 0, 0, 0);
  od = __builtin_amdgcn_mfma_f32_32x32x16_bf16(pa3, PK(l3, h3), od, 0, 0, 0);
#undef PK
}
__device__ __forceinline__ void pv_d0(f32x16* o, int vb, bf16x8 pa0, bf16x8 pa1, bf16x8 pa2, bf16x8 pa3) {
  pv_one<0>(o[0], vb, pa0, pa1, pa2, pa3); pv_one<1>(o[1], vb, pa0, pa1, pa2, pa3); pv_one<2>(o[2], vb, pa0, pa1, pa2, pa3); pv_one<3>(o[3], vb, pa0, pa1, pa2, pa3);
}
__device__ __forceinline__ void attn_unit(const bf16* __restrict__ Qb, const bf16* __restrict__ Kh, const bf16* __restrict__ Vh, bf16* __restrict__ Ob, int seq, char* lds) {
  const int tid = threadIdx.x, wid = tid >> 6, lane = tid & 63, r32 = lane & 31, hi = lane >> 5;
  bf16* V_lds = (bf16*)lds; bf16* K_lds = (bf16*)(lds + 2 * SHM_V);
  float* ws = (float*)(lds + 2 * SHM_V + 2 * SHM_K) + wid * 64; float* li_l = ws; float* al_l = ws + 32;
  float m_reg = -1e30f, l_reg = 0; f32x16 o[4] = {}; bf16x8 qr[8];
  const bf16* Qw = Qb + (long)(wid * QBLK + r32) * LDQ + hi * 8;
#pragma unroll
  for (int d0 = 0; d0 < 8; ++d0) qr[d0] = ld8(Qw + d0 * 16);
  const int sr = tid >> 4, sc = (tid & 15) * 8, vst0 = v_st(sr, sc), vst1 = v_st(32 + sr, sc);
  const int vb0 = (int)(uintptr_t)V_lds + v_rd_base(lane);
  struct { bf16x8 vs0, vs1, ks0, ks1; } sr_[SDEPTH];
#define SLOAD(i, k0) do { sr_[i].vs0 = ld8(&Vh[(long)((k0) + sr) * LDK + sc]); sr_[i].vs1 = ld8(&Vh[(long)((k0) + 32 + sr) * LDK + sc]); \
    sr_[i].ks0 = ld8(&Kh[(long)((k0) + sr) * LDK + sc]); sr_[i].ks1 = ld8(&Kh[(long)((k0) + 32 + sr) * LDK + sc]); } while (0)
#define SWRITE(b, i) do { *(bf16x8*)((char*)V_lds + (b) * SHM_V + vst0) = sr_[i].vs0;          \
    *(bf16x8*)((char*)V_lds + (b) * SHM_V + vst1) = sr_[i].vs1; int kc = sc * 2;               \
    *(bf16x8*)((char*)K_lds + (b) * SHM_K + KSWZ(sr, kc)) = sr_[i].ks0;                       \
    *(bf16x8*)((char*)K_lds + (b) * SHM_K + KSWZ(32 + sr, kc)) = sr_[i].ks1; } while (0)
#define SWAIT() asm volatile("s_waitcnt vmcnt(4)" ::: "memory")
#define RESC(a) do { if (__any((a) < 1.f)) { if (hi == 0) al_l[r32] = (a); asm volatile("s_waitcnt lgkmcnt(0)" ::: "memory"); \
    for (int d = 0; d < 4; ++d) for (int r = 0; r < 16; ++r) o[d][r] *= al_l[crow(r, hi)]; } } while (0)
  f32x16 pA0, pA1, pB0, pB1; float mnA, mnB, alA, alB; bf16x8 pa0, pa1, pa2, pa3; const int NT = seq / KVBLK;
  constexpr int SE = 0, SO = SDEPTH - 1;
  SLOAD(SE, 0); asm volatile("s_waitcnt vmcnt(0)" ::: "memory"); SWRITE(0, SE); __syncthreads();
  qkt(pA0, pA1, K_lds, qr, r32, hi); partialSM(pA0, pA1, m_reg, mnA, alA);
  SLOAD(SO, KVBLK); if (2 < NT) SLOAD(SE, 2 * KVBLK);
  SWAIT(); SWRITE(1, SO); __syncthreads();
  for (int j = 1; j + 1 < NT; j += 2) {
    SBAR(); qkt(pB0, pB1, (bf16*)((char*)K_lds + SHM_K), qr, r32, hi);
    finishSM(pA0, pA1, alA, l_reg, pa0, pa1, pa2, pa3); SBAR();
    SLOAD(SO, (j + SDEPTH) * KVBLK); SBAR();
    pv_d0(o, vb0, pa0, pa1, pa2, pa3); partialSM(pB0, pB1, m_reg, mnB, alB);
    __syncthreads(); SWAIT(); SWRITE(0, SE);
    RESC(alB); __syncthreads();
    SBAR(); qkt(pA0, pA1, K_lds, qr, r32, hi);
    finishSM(pB0, pB1, alB, l_reg, pa0, pa1, pa2, pa3); SBAR();
    if (j + 3 < NT) SLOAD(SE, (j + 1 + SDEPTH) * KVBLK); SBAR();
    pv_d0(o, vb0 + (int)SHM_V, pa0, pa1, pa2, pa3); partialSM(pA0, pA1, m_reg, mnA, alA);
    __syncthreads(); SWAIT(); SWRITE(1, SO);
    RESC(alA); __syncthreads();
  }
  SBAR(); qkt(pB0, pB1, (bf16*)((char*)K_lds + SHM_K), qr, r32, hi);
  finishSM(pA0, pA1, alA, l_reg, pa0, pa1, pa2, pa3); SBAR();
  pv_d0(o, vb0, pa0, pa1, pa2, pa3); partialSM(pB0, pB1, m_reg, mnB, alB);
  __syncthreads(); RESC(alB);
  finishSM(pB0, pB1, alB, l_reg, pa0, pa1, pa2, pa3); SBAR();
  pv_d0(o, vb0 + (int)SHM_V, pa0, pa1, pa2, pa3);
  if (hi == 0) li_l[r32] = l_reg; asm volatile("s_waitcnt lgkmcnt(0)" ::: "memory");
  float rli[16];
#pragma unroll
  for (int r = 0; r < 16; ++r) rli[r] = __builtin_amdgcn_rcpf(li_l[crow(r, hi)]);
  bf16* Ow = Ob + (long)(wid * QBLK) * LDO;
#pragma unroll
  for (int r = 0; r < 16; ++r) { int orow = crow(r, hi);
    for (int d0 = 0; d0 < 4; ++d0) { bf16* p = Ow + (long)orow * LDO + d0 * 32 + r32; const float g = __uint_as_float((unsigned)(*p) << 16); *p = (bf16)f2bf(o[d0][r] * rli[r] * g); } }
  __syncthreads();
#undef SLOAD
#undef SWRITE
#undef SWAIT
#undef RESC
}
#undef KSWZ
#undef SBAR
}
__device__ __forceinline__ void attn_phase_mfma(const Ctx& F, char* ldsg) {
    for (int u = F.bid; u < (MT / 256) * 4; u += F.G) {
        const int rb = u >> 2, h = u & 3, row0 = rb * 256, seq = row0 < MP ? row0 >> 11 : 16;
        const bf16_t* Kh = F.KV + (size_t)(seq * NMEM) * 1024 + h * 128;
        att::attn_unit(F.Q + (size_t)row0 * 512 + h * 128, Kh, Kh + 512, F.FO + (size_t)row0 * 1024 + 512 + h * 128, NMEM, ldsg);
    }
}
__device__ __forceinline__ void final_norm_phase(const Ctx& F) {
    const int gw = F.bid * NWAVES + F.wave, NGW = F.G * NWAVES;
    for (int m = gw; m < MT; m += NGW) {
        f32x4* xr = (f32x4*)(F.out + (size_t)m * DM) + F.lane; const f32x4* gr = (const f32x4*)F.norm_f + F.lane;
        f32x4 v[4]; float s = 0.f;
#pragma unroll
        for (int j = 0; j < 4; ++j) { v[j] = xr[64 * j]; s += (v[j].x * v[j].x + v[j].y * v[j].y) + (v[j].z * v[j].z + v[j].w * v[j].w); }
        const float r = 1.0f / sqrtf(wave_sum(s) * (1.f / DM) + EPS);
#pragma unroll
        for (int j = 0; j < 4; ++j) { const f32x4 g = gr[64 * j]; xr[64 * j] = v[j] * r * g; }
    }
}

struct Args { const float* in[17]; float* out; unsigned char* ws; int ph_lo, ph_hi; };
constexpr int N_PHASES = 7;
__global__ void __launch_bounds__(NTHR, 2) fwd(Args args) {
    extern __shared__ __attribute__((aligned(16))) unsigned char lds_[];
    cg::grid_group grid = cg::this_grid();
    Ctx F;
    F.lds = (LAS unsigned char*)lds_;
    F.tid = threadIdx.x; F.lane = F.tid & 63; F.wave = __builtin_amdgcn_readfirstlane(F.tid >> 6); F.G = gridDim.x; F.bid = blockIdx.x;
    F.xp = args.in[0]; F.xs = args.in[1]; F.memp = args.in[2]; F.mems = args.in[3]; F.norm_in = args.in[4]; F.norm_mem = args.in[5]; F.w_in = args.in[6]; F.w_pool_grp = args.in[7];
    F.pool_scale = args.in[8]; F.w_four_grp = args.in[9]; F.w_kv = args.in[10]; F.w_pool_out = args.in[11]; F.w_four_out = args.in[12]; F.w_attn_out = args.in[13]; F.b_gate = args.in[14];
    F.w_o = args.in[15]; F.norm_f = args.in[16]; F.out = args.out;
    unsigned char* ws = args.ws; unsigned char* ob = (unsigned char*)args.out;
    F.W1T = (bf16_t*)(ws + WS_W1T); F.WGT = (bf16_t*)(ws + WS_WGT); F.WPOT = (bf16_t*)(ws + WS_WPOT); F.WFAT = (bf16_t*)(ws + WS_WFAT); F.WOT = (bf16_t*)(ws + WS_WOT); F.WKVT = (bf16_t*)(ws + WS_WKVT);
    F.MN = (bf16_t*)(ws + WS_MN); F.KV = (bf16_t*)(ws + WS_KV); F.XN = (bf16_t*)(ws + WS_XN); F.PA = (bf16_t*)(ws + WS_PA); F.FO = (bf16_t*)(ws + WS_FO); F.AB = (bf16_t*)(ws + WS_AB);
    F.Q = (bf16_t*)(ws + WS_Q); F.PVF = (bf16_t*)(ob + OUT_PVF); F.Y1 = (bf16_t*)(ob + OUT_Y1); F.MERGED = (bf16_t*)(ws + WS_AB);
    F.TAB = (bf16_t*)(ws + WS_TAB);
    F.stash = ob + OUT_STASH + (size_t)blockIdx.x * 262144;
    if (F.tid < 128) { LAS f32x2* tab = (LAS f32x2*)(F.lds + TAB_OFF); f32x2 v; v.x = cospif((float)F.tid * (1.0f / 64.0f)); v.y = sinpif((float)F.tid * (1.0f / 64.0f)); tab[F.tid] = v; }
    __syncthreads();
    const int lo = args.ph_lo, hi = args.ph_hi;
#define IN(k) (lo <= (k) && (k) < hi)
#define SEAM(k) do { if (IN(k) && IN((k) + 1)) grid.sync(); } while (0)
    if (IN(0)) { p0_prologue(F); }
    SEAM(0);
    if (IN(1)) {
        SchedP1 S{F.G, F.bid, (const char*)F.XN, (const char*)F.W1T, (const char*)F.MN, (const char*)F.WKVT};
        EpiP1 E{F.PVF, F.PA, F.AB, F.FO, F.Q, F.KV};
        pg8::gemm_phase<EpiP1, SchedP1, true, true>(F.lds, S, E);
    }
    SEAM(1);
    if (IN(2)) { pool_phase(F); dft1_mfma<128>(F, F.TAB); dft1_mfma<16>(F, F.TAB + TAB_E116); attn_phase_mfma(F, (char*)lds_); }
    SEAM(2);
    if (IN(3)) { dft2_mfma(F, F.TAB + TAB_E2); }
    SEAM(3);
    if (IN(4)) {
        SchedP3 S{F.G, F.bid, (const char*)F.PA, (const char*)F.XN, (const char*)F.FO, (const char*)F.WPOT, (const char*)F.WGT, (const char*)F.WFAT};
        EpiP3 E{F.stash, F.b_gate, F.MERGED};
        pg8::gemm_phase<EpiP3, SchedP3, true, true>(F.lds, S, E);
    }
    SEAM(4);
    if (IN(5)) {
        SchedP4 S{F.G, F.bid, (const char*)F.MERGED, (const char*)F.WOT};
        EpiP4 E{F.xp, F.xs, F.out};
        pg8::gemm_phase<EpiP4, SchedP4, true, true>(F.lds, S, E);
    }
    SEAM(5);
    if (IN(6)) { final_norm_phase(F); }
#undef IN
#undef SEAM
}

extern "C" void kernel_launch(void* const* d_in, const int* in_sizes, int n_in, void* d_out, int out_size, void* d_ws, size_t ws_size, hipStream_t stream) {
    static int grid = 0;
    if (grid == 0) {
        if (n_in != 17 || in_sizes[0] != MP * DM || in_sizes[1] != MS * DM || out_size != MT * DM || ws_size < WS_END) {
            fprintf(stderr, "kernel_launch: unexpected shapes: n_in %d in0 %d in1 %d out %d ws %zu (need %zu); nothing launched\n", n_in, n_in > 0 ? in_sizes[0] : -1, n_in > 1 ? in_sizes[1] : -1, out_size, ws_size, (size_t)WS_END);
            grid = -1; return; }
        int dev = 0, cus = 0, per_cu = 0;
        if (hipGetDevice(&dev) != hipSuccess || hipDeviceGetAttribute(&cus, hipDeviceAttributeMultiprocessorCount, dev) != hipSuccess) { grid = -1; return; }
        if (hipFuncSetAttribute((const void*)fwd, hipFuncAttributeMaxDynamicSharedMemorySize, LDS_BYTES) != hipSuccess) { fprintf(stderr, "kernel_launch: hipFuncSetAttribute failed\n"); grid = -1; return; }
        if (hipOccupancyMaxActiveBlocksPerMultiprocessor(&per_cu, (const void*)fwd, NTHR, LDS_BYTES) != hipSuccess || per_cu < 1) { fprintf(stderr, "kernel_launch: occupancy query says %d\n", per_cu); per_cu = 1; }
        (void)hipGetLastError();
        grid = cus;
        if (grid > 256) grid = 256;
    }
    if (grid < 0) return;
    Args a{};
    for (int i = 0; i < 17; ++i) a.in[i] = (const float*)d_in[i];
    a.out = (float*)d_out; a.ws = (unsigned char*)d_ws;
#if MK_FUSED
    a.ph_lo = 0; a.ph_hi = N_PHASES;
    void* kargs[] = {&a};
    hipError_t e = hipLaunchCooperativeKernel((const void*)fwd, dim3(grid), dim3(NTHR), kargs, LDS_BYTES, stream);
    if (e != hipSuccess) fprintf(stderr, "kernel_launch: cooperative launch failed: %s (grid %d)\n", hipGetErrorString(e), grid);
#else
    for (int p = 0; p < N_PHASES; ++p) {
        a.ph_lo = p; a.ph_hi = p + 1;
        hipLaunchKernelGGL(fwd, dim3(grid), dim3(NTHR), LDS_BYTES, stream, a);
        const hipError_t le = hipPeekAtLastError();
        if (le != hipSuccess) { fprintf(stderr, "kernel_launch: launch %d failed: %s\n", p, hipGetErrorName(le)); break; }
    }
#endif
}
```

```cpp
#include <hip/hip_runtime.h>
#include <hip/hip_cooperative_groups.h>
#include <cstdio>
#include <cstdint>
namespace cg = cooperative_groups;

#ifndef MK_FUSED
#define MK_FUSED 1
#endif

#ifndef REP_P0
#define REP_P0 1
#endif
#ifndef REP_G
#define REP_G 1
#endif
#define LAS __attribute__((address_space(3)))
typedef unsigned short bf16_t;
typedef short bf16x8 __attribute__((ext_vector_type(8)));
typedef float f32x4 __attribute__((ext_vector_type(4)));
typedef float f32x2 __attribute__((ext_vector_type(2)));
typedef unsigned u32x4 __attribute__((ext_vector_type(4)));
typedef unsigned u32x2 __attribute__((ext_vector_type(2)));

constexpr int DM = 1024;
constexpr int MP = 16 * 2048, MS = 16384, MT = MP + MS;
constexpr int NSEQ = 17, NMEM = 256, MMEM = NSEQ * NMEM;
constexpr int INW = 7168;
constexpr float EPS = 1e-6f;
constexpr int NTHR = 512, NWAVES = 8;

constexpr size_t MiB = 1u << 20;
constexpr size_t WS_CTL = 0, CTL_ZERO_BYTES = 65536;
constexpr size_t WS_W1T = 1 * MiB;
constexpr size_t WS_WGT = 10 * MiB;
constexpr size_t WS_WPOT = 16 * MiB, WS_WFAT = 18 * MiB, WS_WOT = 20 * MiB, WS_WKVT = 22 * MiB;
constexpr size_t WS_MN = 24 * MiB;
constexpr size_t WS_KV = 33 * MiB;
constexpr size_t WS_XN = 48 * MiB;
constexpr size_t WS_PA = 144 * MiB;
constexpr size_t WS_FO = 240 * MiB;
constexpr size_t WS_AB = 336 * MiB;
constexpr size_t WS_Q = 432 * MiB;
constexpr size_t WS_END = 480 * MiB;
constexpr size_t OUT_PVF = 0, OUT_Y1 = 96 * MiB, OUT_STASH = 0;

constexpr int RING_BYTES = 131072;
constexpr int MISC_OFF = RING_BYTES;
constexpr int TAB_OFF = RING_BYTES + 1024;
constexpr int LDS_BYTES = 147456;

__device__ __forceinline__ unsigned f2bf(float f) { unsigned u = __builtin_bit_cast(unsigned, f); return (u + 0x7fffu + ((u >> 16) & 1u)) >> 16; }
__device__ __forceinline__ unsigned pk2(float lo, float hi) { return f2bf(lo) | (f2bf(hi) << 16); }
__device__ __forceinline__ float bflo(unsigned u) { return __builtin_bit_cast(float, u << 16); }
__device__ __forceinline__ float bfhi(unsigned u) { return __builtin_bit_cast(float, u & 0xffff0000u); }
__device__ __forceinline__ unsigned cvt_pk_bf16(float lo, float hi) { unsigned r; asm volatile("v_cvt_pk_bf16_f32 %0, %1, %2" : "=v"(r) : "v"(lo), "v"(hi)); return r; }
__device__ __forceinline__ float sigmoid_f(float v) { return __builtin_amdgcn_rcpf(1.0f + __expf(-v)); }
__device__ __forceinline__ float silu_f(float v) { return v * sigmoid_f(v); }
__device__ __forceinline__ float wave_sum(float v) {
#pragma unroll
    for (int o = 1; o < 64; o <<= 1) v += __shfl_xor(v, o);
    return v;
}
__device__ __forceinline__ float wave_max(float v) {
#pragma unroll
    for (int o = 1; o < 64; o <<= 1) v = fmaxf(v, __shfl_xor(v, o));
    return v;
}
#define LDS_WAIT() asm volatile("s_waitcnt lgkmcnt(0)" ::: "memory")

namespace pg8 {
constexpr int BM = 256, BK = 64, HALF = 128, HTB = HALF * BK * 2, STAGE_BYTES = 8 * HTB, NXCD = 8, WGM = 8;
constexpr int KP = 1024;
constexpr size_t TSTEP = (size_t)BM * KP * 2;
__device__ __forceinline__ int lds_byte(int r, int c) { const int st = (r >> 4) * 2 + (c >> 5), rr = r & 15, cc = c & 31, ob = rr * 64 + cc * 2; return st * 1024 + (ob ^ (((ob >> 9) & 1) << 5)); }
__device__ __forceinline__ void stage_rc(int b, int& R, int& C) { const int st = b / 1024, sb = b % 1024, swz = sb ^ (((sb >> 9) & 1) << 5); R = (st >> 1) * 16 + swz / 64; C = (st & 1) * 32 + (swz % 64) / 2; }
__device__ __forceinline__ int perm32(int rho) { const int n = rho >> 4, i = rho & 15; return 8 * (i >> 2) + 4 * n + (i & 3); }

struct Unit { const char* A; const char* B; int nt, pm, pn, seg; };

__device__ __forceinline__ void tile_order(int L, int nM, int nN, int& pm, int& pn) {
    const int nwg = nM * nN; int wgid = L;
    { const int q = nwg / NXCD, r = nwg % NXCD, xcd = wgid % NXCD, off = wgid / NXCD; wgid = (xcd < r ? xcd * (q + 1) : r * (q + 1) + (xcd - r) * q) + off; }
    const int nig = WGM * nN, gid = wgid / nig, fm = gid * WGM, gsz = (nM - fm) < WGM ? (nM - fm) : WGM;
    pm = fm + ((wgid % nig) % gsz); pn = (wgid % nig) / gsz;
}

template <class Epi, class Sched, bool ALIGN_EPI, bool SP2>
__device__ __forceinline__ void gemm_phase(LAS unsigned char* lds, const Sched& S, const Epi& E) {
    const int tid = threadIdx.x, wid = __builtin_amdgcn_readfirstlane(tid >> 6), lane = tid & 63, wr = wid >> 2, wc = wid & 3, fr = lane & 15, fq = lane >> 4;
    unsigned voffA[2], voffB[2];
#pragma unroll
    for (int i = 0; i < 2; ++i) { int R, C; stage_rc(tid * 16 + i * 8192, R, C); const int Rb = Epi::PERM ? ((R & ~31) + perm32(R & 31)) : R;
        voffA[i] = (unsigned)(R * KP + C) * 2u; voffB[i] = (unsigned)(Rb * KP + C) * 2u; }
    const size_t kstep = (size_t)(BK * 2);
    const size_t hstep = (size_t)HALF * KP * 2;
    const unsigned ldsw = (unsigned)wid * 1024u;
    const int aoff = lds_byte(wr * 64 + fr, fq * 8), boff = lds_byte(wc * 32 + fr, fq * 8);
#define PG8_SA(b, h) (((b) * 2 + (h)) * HTB)
#define PG8_SB(b, h) ((4 + (b) * 2 + (h)) * HTB)
#define PG8_STAGE(bufoff, gbase, voff) do { _Pragma("unroll") for (int _i = 0; _i < 2; ++_i) \
        __builtin_amdgcn_global_load_lds((const unsigned*)((const char*)(gbase) + (voff)[_i]), (LAS unsigned*)(lds + (bufoff) + ldsw + _i * 8192), 16, 0, 0); } while (0)
#define PG8_LDA(dst, b, h) do { _Pragma("unroll") for (int m = 0; m < 4; ++m) _Pragma("unroll") for (int k = 0; k < 2; ++k) dst[m][k] = *(const LAS bf16x8*)(lds + PG8_SA(b, h) + aoff + m * 2048 + k * 1024); } while (0)
#define PG8_LDB(dst, b, h) do { _Pragma("unroll") for (int n = 0; n < 2; ++n) _Pragma("unroll") for (int k = 0; k < 2; ++k) dst[n][k] = *(const LAS bf16x8*)(lds + PG8_SB(b, h) + boff + n * 2048 + k * 1024); } while (0)
#define PG8_MMA(ai, bj, At, Bt) do { __builtin_amdgcn_s_setprio(1); _Pragma("unroll") for (int m = 0; m < 4; ++m) _Pragma("unroll") for (int n = 0; n < 2; ++n) _Pragma("unroll") for (int k = 0; k < 2; ++k) \
        acc[ai][bj][m][n] = __builtin_amdgcn_mfma_f32_16x16x32_bf16(Bt[n][k], At[m][k], acc[ai][bj][m][n], 0, 0, 0); __builtin_amdgcn_s_setprio(0); } while (0)
#define PG8_WAIT_V(n) asm volatile("s_waitcnt vmcnt(" #n ")" ::: "memory")
#define PG8_WAIT_L(n) asm volatile("s_waitcnt lgkmcnt(" #n ")" ::: "memory")
#define PG8_BAR __builtin_amdgcn_s_barrier()
#define PG8_SCHED __builtin_amdgcn_sched_barrier(0)
    Unit cur, nxt; int ui = 0;
    if (!S.next(0, cur)) return;
    f32x4 acc[2][2][4][2];
#pragma unroll
    for (int a = 0; a < 2; ++a)
#pragma unroll
        for (int b = 0; b < 2; ++b)
#pragma unroll
            for (int m = 0; m < 4; ++m)
#pragma unroll
                for (int n = 0; n < 2; ++n) acc[a][b][m][n] = (f32x4){0.f, 0.f, 0.f, 0.f};
    bf16x8 At[4][2], B0[2][2], B1[2][2];
    const char* cA = cur.A; const char* cB = cur.B;
    if constexpr (SP2) {
        PG8_STAGE(PG8_SB(0, 0), cB, voffB); PG8_STAGE(PG8_SB(0, 1), cB + hstep, voffB); PG8_STAGE(PG8_SA(0, 0), cA, voffA); PG8_STAGE(PG8_SA(0, 1), cA + hstep, voffA);
        if (wr == 1) PG8_BAR;
        PG8_WAIT_V(2); PG8_BAR;
        PG8_STAGE(PG8_SB(1, 0), cB + kstep, voffB); PG8_STAGE(PG8_SA(1, 0), cA + kstep, voffA); PG8_STAGE(PG8_SB(1, 1), cB + hstep + kstep, voffB);
        PG8_WAIT_V(6); PG8_BAR;
    } else {
        PG8_STAGE(PG8_SB(0, 0), cB, voffB); PG8_STAGE(PG8_SA(0, 0), cA, voffA); PG8_STAGE(PG8_SB(0, 1), cB + hstep, voffB); PG8_STAGE(PG8_SA(0, 1), cA + hstep, voffA);
        if (wr == 1) PG8_BAR;
        PG8_WAIT_V(4); PG8_BAR;
        PG8_STAGE(PG8_SB(1, 0), cB + kstep, voffB); PG8_STAGE(PG8_SA(1, 0), cA + kstep, voffA); PG8_STAGE(PG8_SB(1, 1), cB + hstep + kstep, voffB);
        PG8_WAIT_V(6); PG8_BAR;
    }
    for (;;) {
        const bool has_next = S.next(ui + 1, nxt);
        const char* nA = has_next ? nxt.A : cA; const char* nB = has_next ? nxt.B : cB;
        const int nt = cur.nt;
        for (int t = 0; t < nt; t += 2) {
            const bool last = (t == nt - 2);
            const char* a1 = cA + (size_t)(t + 1) * kstep;
            const char* a2 = last ? nA : cA + (size_t)(t + 2) * kstep; const char* b2 = last ? nB : cB + (size_t)(t + 2) * kstep;
            const char* a3 = a2 + kstep; const char* b3 = b2 + kstep;
            if constexpr (SP2) {
            PG8_LDB(B0, 0, 0); PG8_LDB(B1, 0, 1); PG8_SCHED; PG8_LDA(At, 0, 0); PG8_STAGE(PG8_SA(1, 1), a1 + hstep, voffA);
            PG8_WAIT_V(8); PG8_WAIT_L(0); PG8_BAR; PG8_MMA(0, 0, At, B0); PG8_MMA(0, 1, At, B1); PG8_BAR; PG8_SCHED;
            PG8_LDA(At, 0, 1); PG8_STAGE(PG8_SB(0, 0), b2, voffB); PG8_STAGE(PG8_SB(0, 1), b2 + hstep, voffB); PG8_STAGE(PG8_SA(0, 0), a2, voffA);
            PG8_WAIT_V(8); PG8_WAIT_L(0); PG8_BAR; PG8_MMA(1, 0, At, B0); PG8_MMA(1, 1, At, B1); PG8_BAR; PG8_SCHED;
            PG8_LDB(B0, 1, 0); PG8_LDB(B1, 1, 1); PG8_SCHED; PG8_LDA(At, 1, 0); PG8_STAGE(PG8_SA(0, 1), a2 + hstep, voffA);
            PG8_WAIT_V(8); PG8_WAIT_L(0); PG8_BAR; PG8_MMA(0, 0, At, B0); PG8_MMA(0, 1, At, B1); PG8_BAR; PG8_SCHED;
            PG8_LDA(At, 1, 1); PG8_STAGE(PG8_SB(1, 0), b3, voffB); PG8_STAGE(PG8_SB(1, 1), b3 + hstep, voffB); PG8_STAGE(PG8_SA(1, 0), a3, voffA);
            PG8_WAIT_V(8); PG8_WAIT_L(0); PG8_BAR; PG8_MMA(1, 0, At, B0); PG8_MMA(1, 1, At, B1); PG8_BAR; PG8_SCHED;
            } else {
            PG8_LDB(B0, 0, 0); PG8_SCHED; PG8_LDA(At, 0, 0); PG8_STAGE(PG8_SA(1, 1), a1 + hstep, voffA);
            PG8_WAIT_L(8); PG8_BAR; PG8_WAIT_L(0); PG8_MMA(0, 0, At, B0); PG8_BAR; PG8_SCHED;
            PG8_LDB(B1, 0, 1); PG8_STAGE(PG8_SB(0, 0), b2, voffB);
            PG8_BAR; PG8_WAIT_L(0); PG8_MMA(0, 1, At, B1); PG8_BAR;
            PG8_LDA(At, 0, 1); PG8_STAGE(PG8_SA(0, 0), a2, voffA);
            PG8_BAR; PG8_WAIT_L(0); PG8_MMA(1, 0, At, B0); PG8_BAR; PG8_SCHED;
            PG8_STAGE(PG8_SB(0, 1), b2 + hstep, voffB);
            PG8_WAIT_V(6); PG8_BAR; PG8_MMA(1, 1, At, B1); PG8_BAR;
            PG8_LDB(B0, 1, 0); PG8_SCHED; PG8_LDA(At, 1, 0); PG8_STAGE(PG8_SA(0, 1), a2 + hstep, voffA);
            PG8_WAIT_L(8); PG8_BAR; PG8_WAIT_L(0); PG8_MMA(0, 0, At, B0); PG8_BAR; PG8_SCHED;
            PG8_LDB(B1, 1, 1); PG8_STAGE(PG8_SB(1, 0), b3, voffB);
            PG8_BAR; PG8_WAIT_L(0); PG8_MMA(0, 1, At, B1); PG8_BAR;
            PG8_LDA(At, 1, 1); PG8_STAGE(PG8_SA(1, 0), a3, voffA);
            PG8_BAR; PG8_WAIT_L(0); PG8_MMA(1, 0, At, B0); PG8_BAR; PG8_SCHED;
            PG8_STAGE(PG8_SB(1, 1), b3 + hstep, voffB);
            PG8_WAIT_V(6); PG8_BAR; PG8_MMA(1, 1, At, B1); PG8_BAR;
            }
        }
        if constexpr (ALIGN_EPI) { if (wr == 0) PG8_BAR; }
        E(acc, cur, wr, wc, fr, fq);
        if (!has_next) break;
#pragma unroll
        for (int a = 0; a < 2; ++a)
#pragma unroll
            for (int b = 0; b < 2; ++b)
#pragma unroll
                for (int m = 0; m < 4; ++m)
#pragma unroll
                    for (int n = 0; n < 2; ++n) acc[a][b][m][n] = (f32x4){0.f, 0.f, 0.f, 0.f};
        cur = nxt; cA = nA; cB = nB; ++ui;
        if constexpr (ALIGN_EPI) { if (wr == 1) PG8_BAR; }
    }
    PG8_WAIT_V(0);
    if constexpr (!ALIGN_EPI) { if (wr == 0) PG8_BAR; }
    PG8_BAR;
#undef PG8_SA
#undef PG8_SB
#undef PG8_STAGE
#undef PG8_LDA
#undef PG8_LDB
#undef PG8_MMA
#undef PG8_WAIT_V
#undef PG8_WAIT_L
#undef PG8_BAR
#undef PG8_SCHED
}
}
using pg8::Unit;


#define XB_TMO      128
#define XB_XCNT(j)  (256  + 64 * (j))
#define XB_XSUB(j)  (1280 + 64 * (j))
#define XB_XGEN(j)  (2304 + 64 * (j))
#define XB_TOP      3328
#define XB_TOPGEN   3392
#define XCD_BAR_WORDS 3456
#define XB_SPIN_CAP (1u << 18)
__device__ __forceinline__ unsigned xb_ld(unsigned* p)              { return __hip_atomic_load(p, __ATOMIC_RELAXED, __HIP_MEMORY_SCOPE_AGENT); }
__device__ __forceinline__ unsigned xb_add(unsigned* p, unsigned v) { return __hip_atomic_fetch_add(p, v, __ATOMIC_RELAXED, __HIP_MEMORY_SCOPE_AGENT); }
__device__ __forceinline__ unsigned xb_xcc_id() { return (unsigned)__builtin_amdgcn_s_getreg((3 << 11) | 20) & 0xFu; }
#define XB_SPIN(cond, bar) do { unsigned _sp = 0; while (cond) { __builtin_amdgcn_s_sleep(1); \
    if ((++_sp & 255u) == 0u) { if (xb_ld(&(bar)[XB_TMO])) break; if (_sp > XB_SPIN_CAP) { atomicAdd(&(bar)[XB_TMO], 1u); break; } } } } while (0)
struct XcdBarrier { unsigned* bar; unsigned x; volatile LAS unsigned* st; };
__device__ __forceinline__ XcdBarrier xcd_barrier_post(unsigned* bar, volatile LAS unsigned* st) {
    XcdBarrier b; b.bar = bar; b.x = xb_xcc_id(); b.st = st;
    if (threadIdx.x == 0) (void)xb_add(&bar[XB_XCNT(b.x)], 1u);
    return b;
}
__device__ __forceinline__ void xcd_barrier_complete(unsigned* bar, unsigned x, unsigned& nloc, unsigned& nx) {
    const unsigned G = gridDim.x * gridDim.y * gridDim.z;
    unsigned sum, cnt, mine, sp = 0u;
    for (;;) {
        sum = 0u; cnt = 0u; mine = 0u;
#pragma unroll
        for (unsigned j = 0; j < 16; ++j) { const unsigned c = xb_ld(&bar[XB_XCNT(j)]); sum += c; cnt += (c > 0u) ? 1u : 0u; mine = (j == x) ? c : mine; }
        if (sum == G) break;
        __builtin_amdgcn_s_sleep(1);
        if ((++sp & 255u) == 0u) { if (xb_ld(&bar[XB_TMO])) break; if (sp > XB_SPIN_CAP) { atomicAdd(&bar[XB_TMO], 1u); break; } }
    }
    nloc = mine > 0u ? mine : 1u; nx = cnt > 0u ? cnt : 1u;
}
__device__ __forceinline__ void xcd_barrier(const XcdBarrier& b) {
    asm volatile("s_waitcnt vmcnt(0)" ::: "memory");
    __syncthreads();
    if (threadIdx.x == 0) {
        unsigned* bar = b.bar;
        __builtin_amdgcn_s_waitcnt(0);
        unsigned nloc = b.st[0], nx = b.st[1];
        if (nloc == 0u) { xcd_barrier_complete(bar, b.x, nloc, nx); b.st[0] = nloc; b.st[1] = nx; }
        const unsigned old = xb_add(&bar[XB_XSUB(b.x)], 1u);
        const unsigned gen = old / nloc;
        if (old + 1u == (gen + 1u) * nloc) {
            __builtin_amdgcn_fence(__ATOMIC_RELEASE, "agent");
            asm volatile("s_waitcnt vmcnt(0)" ::: "memory");
            const unsigned og = xb_add(&bar[XB_TOP], 1u);
            const unsigned tg = og / nx;
            if (og + 1u == (tg + 1u) * nx) xb_add(&bar[XB_TOPGEN], 1u);
            else XB_SPIN(xb_ld(&bar[XB_TOPGEN]) == tg, bar);
            __builtin_amdgcn_fence(__ATOMIC_ACQUIRE, "agent");
            xb_add(&bar[XB_XGEN(b.x)], 1u);
            asm volatile("s_waitcnt vmcnt(0)" ::: "memory");
        } else {
            XB_SPIN(xb_ld(&bar[XB_XGEN(b.x)]) == gen, bar);
            __builtin_amdgcn_fence(__ATOMIC_ACQUIRE, "agent");
            asm volatile("s_waitcnt vmcnt(0)" ::: "memory");
        }
    }
    __syncthreads();
}
struct Ctx {
    LAS unsigned char* lds;
    int tid, lane, wave, G, bid;
    const float *xp, *xs, *memp, *mems, *norm_in, *norm_mem, *w_in, *w_pool_grp, *pool_scale, *w_four_grp, *w_kv, *w_pool_out, *w_four_out, *w_attn_out, *b_gate, *w_o, *norm_f;
    float* out;
    bf16_t *W1T, *WGT, *WPOT, *WFAT, *WOT, *WKVT, *MN, *KV, *XN, *PA, *FO, *AB, *Q, *PVF, *Y1, *MERGED, *TAB;
    unsigned char* stash;
};

struct SchedP1 {
    int G, c; const char *XN, *W1T, *MN, *WKVT;
    __device__ __forceinline__ bool next(int i, Unit& u) const {
        int L = i * G + c; u.nt = 16;
        if (L < 192 * 18) { pg8::tile_order(L, 192, 18, u.pm, u.pn); u.A = XN + (size_t)u.pm * pg8::TSTEP; u.B = W1T + (size_t)u.pn * pg8::TSTEP; u.seg = 0; return true; }
        L -= 192 * 18; if (L >= 17 * 4) return false;
        u.pm = L % 17; u.pn = L / 17; u.A = MN + (size_t)u.pm * pg8::TSTEP; u.B = WKVT + (size_t)u.pn * pg8::TSTEP; u.seg = 1; return true;
    }
};
struct EpiP1 {
    static constexpr bool PERM = true;
    bf16_t *PVF, *SPG, *AB, *FO, *Q, *KV;
    __device__ __forceinline__ void operator()(const f32x4 (&acc)[2][2][4][2], const Unit& u, int wr, int wc, int fr, int fq) const {
        bf16_t* base; int ld, colt, act; const int pn = u.pn;
        if (u.seg == 1) { base = KV; ld = 1024; colt = pn * 256; act = 0; }
        else if (pn < 4) { base = PVF; ld = 1024; colt = pn * 256; act = 0; }
        else if (pn < 8) { base = SPG; ld = 1024; colt = (pn - 4) * 256; act = 1; }
        else if (pn < 12) { base = AB; ld = 1024; colt = (pn - 8) * 256; act = 0; }
        else if (pn < 14) { base = FO; ld = 1024; colt = (pn - 12) * 256; act = 1; }
        else if (pn < 16) { base = Q; ld = 512; colt = (pn - 14) * 256; act = 0; }
        else { base = FO; ld = 1024; colt = 512 + (pn - 16) * 256; act = 1; }
        const int row0 = u.pm * 256 + wr * 64 + fr, col0 = colt + wc * 32 + 8 * fq;
#pragma unroll
        for (int ai = 0; ai < 2; ++ai)
#pragma unroll
            for (int m = 0; m < 4; ++m) { bf16_t* rowp = base + (size_t)(row0 + ai * 128 + m * 16) * ld + col0;
#pragma unroll
                for (int bj = 0; bj < 2; ++bj) { f32x4 v0 = acc[ai][bj][m][0], v1 = acc[ai][bj][m][1];
                    if (act) {
#pragma unroll
                        for (int j = 0; j < 4; ++j) { v0[j] = silu_f(v0[j]); v1[j] = silu_f(v1[j]); } }
                    u32x4 w; w.x = cvt_pk_bf16(v0[0], v0[1]); w.y = cvt_pk_bf16(v0[2], v0[3]); w.z = cvt_pk_bf16(v1[0], v1[1]); w.w = cvt_pk_bf16(v1[2], v1[3]);
                    *(u32x4*)(rowp + bj * 128) = w; } }
    }
};
struct SchedP3 {
    int G, c; const char *PA, *XN, *FO, *WPOT, *WGT, *WFAT;
    __device__ __forceinline__ bool next(int i, Unit& u) const {
        const int ti = i / 6, seg = i - 6 * ti, L = ti * G + c; if (L >= 192 * 4) return false;
        pg8::tile_order(L, 192, 4, u.pm, u.pn); u.seg = seg;
        const size_t am = (size_t)u.pm * pg8::TSTEP, bn = (size_t)u.pn * pg8::TSTEP;
        if (seg == 0) { u.A = PA + am; u.B = WPOT + bn; u.nt = 16; }
        else if (seg == 2) { u.A = FO + am; u.B = WFAT + bn; u.nt = 8; }
        else if (seg == 4) { u.A = FO + am + 1024; u.B = WFAT + bn + 1024; u.nt = 8; }
        else { u.A = XN + am; u.B = WGT + (size_t)(4 * (seg >> 1) + u.pn) * pg8::TSTEP; u.nt = 16; }
        return true;
    }
};
struct EpiP3 {
    static constexpr bool PERM = true;
    unsigned char* stash; const float* bgate; bf16_t* MERGED;
    __device__ __forceinline__ void operator()(const f32x4 (&acc)[2][2][4][2], const Unit& u, int wr, int wc, int fr, int fq) const {
        const int tid = threadIdx.x, seg = u.seg;
        const unsigned toff = (unsigned)tid * 16u; const __amdgpu_buffer_rsrc_t srs = __builtin_amdgcn_make_buffer_rsrc((void*)stash, (short)0, 262144, 0x00020000);
        if ((seg & 1) == 0) {
#pragma unroll
            for (int ai = 0; ai < 2; ++ai)
#pragma unroll
                for (int bj = 0; bj < 2; ++bj)
#pragma unroll
                    for (int m = 0; m < 4; ++m) { const f32x4 v0 = acc[ai][bj][m][0], v1 = acc[ai][bj][m][1];
                        u32x4 w; w.x = cvt_pk_bf16(v0[0], v0[1]); w.y = cvt_pk_bf16(v0[2], v0[3]); w.z = cvt_pk_bf16(v1[0], v1[1]); w.w = cvt_pk_bf16(v1[2], v1[3]);
                        __builtin_amdgcn_raw_buffer_store_b128(w, srs, toff, ((ai * 2 + bj) * 4 + m) * 8192, 0); }
        } else {
            const int bcol0 = (seg >> 1) * 1024 + u.pn * 256 + wc * 32 + 8 * fq;
            const int row0 = u.pm * 256 + wr * 64 + fr, col0 = u.pn * 256 + wc * 32 + 8 * fq;
#pragma unroll
            for (int bj = 0; bj < 2; ++bj) {
                const f32x4 b0 = *(const f32x4*)(bgate + bcol0 + bj * 128), b1 = *(const f32x4*)(bgate + bcol0 + bj * 128 + 4);
#pragma unroll
                for (int ai = 0; ai < 2; ++ai)
#pragma unroll
                    for (int m = 0; m < 4; ++m) { const int j = (ai * 2 + bj) * 4 + m;
                        const u32x4 yv = __builtin_amdgcn_raw_buffer_load_b128(srs, toff, j * 8192, 0);
                        const f32x4 a0 = acc[ai][bj][m][0] + b0, a1 = acc[ai][bj][m][1] + b1;
                        float r[8];
                        r[0] = sigmoid_f(a0[0]) * bflo(yv.x); r[1] = sigmoid_f(a0[1]) * bfhi(yv.x); r[2] = sigmoid_f(a0[2]) * bflo(yv.y); r[3] = sigmoid_f(a0[3]) * bfhi(yv.y);
                        r[4] = sigmoid_f(a1[0]) * bflo(yv.z); r[5] = sigmoid_f(a1[1]) * bfhi(yv.z); r[6] = sigmoid_f(a1[2]) * bflo(yv.w); r[7] = sigmoid_f(a1[3]) * bfhi(yv.w);
                        if (seg >= 3) { const u32x4 mv = __builtin_amdgcn_raw_buffer_load_b128(srs, toff, 131072 + j * 8192, 0);
                            r[0] += bflo(mv.x); r[1] += bfhi(mv.x); r[2] += bflo(mv.y); r[3] += bfhi(mv.y); r[4] += bflo(mv.z); r[5] += bfhi(mv.z); r[6] += bflo(mv.w); r[7] += bfhi(mv.w); }
                        u32x4 w; w.x = cvt_pk_bf16(r[0], r[1]); w.y = cvt_pk_bf16(r[2], r[3]); w.z = cvt_pk_bf16(r[4], r[5]); w.w = cvt_pk_bf16(r[6], r[7]);
                        if (seg < 5) __builtin_amdgcn_raw_buffer_store_b128(w, srs, toff, 131072 + j * 8192, 0);
                        else *(u32x4*)(MERGED + (size_t)(row0 + ai * 128 + m * 16) * 1024 + col0 + bj * 128) = w;
                        if (m & 1) asm volatile("" ::: "memory"); }
            }
        }
    }
};
struct SchedP4 {
    int G, c; const char *MERGED, *WOT;
    __device__ __forceinline__ bool next(int i, Unit& u) const {
        const int L = i * G + c; if (L >= 192 * 4) return false;
        pg8::tile_order(L, 192, 4, u.pm, u.pn); u.A = MERGED + (size_t)u.pm * pg8::TSTEP; u.B = WOT + (size_t)u.pn * pg8::TSTEP; u.nt = 16; u.seg = 0; return true;
    }
};
struct EpiP4 {
    static constexpr bool PERM = false;
    const float *xp, *xs; float* out;
    __device__ __forceinline__ void operator()(const f32x4 (&acc)[2][2][4][2], const Unit& u, int wr, int wc, int fr, int fq) const {
        const int row0 = u.pm * 256 + wr * 64 + fr, col0 = u.pn * 256 + wc * 32 + 4 * fq;
        const float* xb = (u.pm < MP / 256) ? xp : xs - (size_t)MP * DM;
#pragma unroll
        for (int ai = 0; ai < 2; ++ai)
#pragma unroll
            for (int m = 0; m < 4; ++m) { const size_t off = (size_t)(row0 + ai * 128 + m * 16) * DM + col0;
#pragma unroll
                for (int bj = 0; bj < 2; ++bj)
#pragma unroll
                    for (int n = 0; n < 2; ++n) { const f32x4 xv = *(const f32x4*)(xb + off + bj * 128 + n * 16); *(f32x4*)(out + off + bj * 128 + n * 16) = xv + acc[ai][bj][m][n]; }
                asm volatile("" ::: "memory"); }
    }
};

__device__ __forceinline__ void transpose_item(const float* W, int ldw, bf16_t* WT, int nblk, LAS float* scr, int item, int lane) {
    const int kb = item / nblk, nb = item % nblk, k0 = 64 * kb, n0 = 32 * nb;
#pragma unroll 8
    for (int i = 0; i < 32; ++i) { const int kk = 2 * i + (lane >> 5); scr[kk * 33 + (lane & 31)] = W[(size_t)(k0 + kk) * ldw + n0 + (lane & 31)]; }
    LDS_WAIT(); asm volatile("" ::: "memory");
    const int c = lane & 7;
#pragma unroll
    for (int j = 0; j < 4; ++j) { const int n = (lane >> 3) + 8 * j; const LAS float* s = scr + (8 * c) * 33 + n;
        u32x4 o; o.x = pk2(s[0 * 33], s[1 * 33]); o.y = pk2(s[2 * 33], s[3 * 33]); o.z = pk2(s[4 * 33], s[5 * 33]); o.w = pk2(s[6 * 33], s[7 * 33]);
        *(u32x4*)(WT + (size_t)(n0 + n) * 1024 + k0 + 8 * c) = o; }
    LDS_WAIT(); asm volatile("" ::: "memory");
}
__device__ __forceinline__ void rms_row_to_bf16(const float* xrow, const float* gain, bf16_t* orow, int lane) {
    const f32x4* xr = (const f32x4*)xrow + lane; const f32x4* gr = (const f32x4*)gain + lane;
    f32x4 v[4]; float s = 0.f;
#pragma unroll
    for (int j = 0; j < 4; ++j) { v[j] = xr[64 * j]; s += (v[j].x * v[j].x + v[j].y * v[j].y) + (v[j].z * v[j].z + v[j].w * v[j].w); }
    const float r = 1.0f / sqrtf(wave_sum(s) * (1.f / DM) + EPS);
    u32x2* o8 = (u32x2*)orow + lane;
#pragma unroll
    for (int j = 0; j < 4; ++j) { const f32x4 g = gr[64 * j]; u32x2 w; w.x = pk2(v[j].x * r * g.x, v[j].y * r * g.y); w.y = pk2(v[j].z * r * g.z, v[j].w * r * g.w); o8[64 * j] = w; }
}
__device__ __forceinline__ void fold_item(const Ctx& F, int item) {
    LAS float* As = (LAS float*)F.lds;
    LAS float* Bs = (LAS float*)(F.lds + 16384);
    LAS float* Ts = (LAS float*)(F.lds + 32768);
    const LAS f32x2* tab = (const LAS f32x2*)(F.lds + TAB_OFF);
    const int tid = F.tid, tk = tid & 63, tj = tid >> 6;
    float acc[8];
#pragma unroll
    for (int j = 0; j < 8; ++j) acc[j] = 0.f;
    if (item < 256) {
        const int g = item >> 6, k0 = ((item >> 2) & 15) * 64, j0 = (item & 3) * 64;
        for (int c0 = 0; c0 < 256; c0 += 32) {
            __syncthreads();
#pragma unroll
            for (int i = 0; i < 4; ++i) { const int idx = tid + 512 * i; { const int kk = idx >> 5, cc = idx & 31; As[kk * 33 + cc] = F.w_in[(size_t)(k0 + kk) * INW + g * 256 + c0 + cc]; }
                { const int cc = idx >> 6, jj = idx & 63; Bs[cc * 64 + jj] = F.w_pool_grp[(size_t)(g * 256 + c0 + cc) * 256 + j0 + jj]; } }
            __syncthreads();
#pragma unroll 8
            for (int cc = 0; cc < 32; ++cc) { const float a = As[tk * 33 + cc];
#pragma unroll
                for (int j = 0; j < 8; ++j) acc[j] += a * Bs[cc * 64 + tj * 8 + j]; }
        }
#pragma unroll
        for (int j = 0; j < 8; ++j) { const int n = g * 256 + j0 + tj * 8 + j; F.W1T[(size_t)n * 1024 + k0 + tk] = (bf16_t)f2bf(acc[j] * F.pool_scale[n]); }
    } else {
        const int it = item - 256, g = it >> 6, sn = (it >> 5) & 1, k0 = ((it >> 1) & 15) * 64, j0 = (it & 1) * 64;
        __syncthreads();
        { const int c = tid & 127, jq = tid >> 7; float t[16];
#pragma unroll
            for (int j = 0; j < 16; ++j) t[j] = 0.f;
            for (int d = 0; d < 128; ++d) { const f32x2 cs = tab[(c * d) & 127]; const float w = sn ? cs.y : cs.x;
                const f32x4* wp = (const f32x4*)(F.w_four_grp + (size_t)(g * 128 + d) * 128 + j0 + jq * 16);
#pragma unroll
                for (int q = 0; q < 4; ++q) { const f32x4 x = wp[q]; t[4 * q] += w * x.x; t[4 * q + 1] += w * x.y; t[4 * q + 2] += w * x.z; t[4 * q + 3] += w * x.w; } }
#pragma unroll
            for (int j = 0; j < 16; ++j) Ts[c * 64 + jq * 16 + j] = t[j] * 0.08838834764831845f; }
        for (int c0 = 0; c0 < 128; c0 += 32) {
            __syncthreads();
#pragma unroll
            for (int i = 0; i < 4; ++i) { const int idx = tid + 512 * i; const int kk = idx >> 5, cc = idx & 31; As[kk * 33 + cc] = F.w_in[(size_t)(k0 + kk) * INW + 2048 + g * 128 + c0 + cc]; }
            __syncthreads();
#pragma unroll 8
            for (int cc = 0; cc < 32; ++cc) { const float a = As[tk * 33 + cc];
#pragma unroll
                for (int j = 0; j < 8; ++j) acc[j] += a * Ts[(c0 + cc) * 64 + tj * 8 + j]; }
        }
#pragma unroll
        for (int j = 0; j < 8; ++j) { const int n = 2048 + sn * 512 + g * 128 + j0 + tj * 8 + j; F.W1T[(size_t)n * 1024 + k0 + tk] = (bf16_t)f2bf(acc[j]); }
    }
    __syncthreads();
}
__device__ __forceinline__ void build_tables(const Ctx& F, bf16_t* T);
__device__ __forceinline__ void p0_prologue(const Ctx& F) {
    build_tables(F, F.TAB);
    for (int it = F.bid; it < 512; it += F.G) fold_item(F, it);
    __syncthreads();
    LAS float* scr = (LAS float*)(F.lds + F.wave * 16384);
    const int gw = F.bid * NWAVES + F.wave, NGW = F.G * NWAVES;
    constexpr int I0 = 16 * 32, I1 = 16 * 16, I4 = 16 * 96, I5 = 16 * 32, I6 = 8 * 32;
    constexpr int NITEMS = I0 + 3 * I1 + I4 + I5 + 2 * I6 + 2 * I5;
    for (int it = gw; it < NITEMS; it += NGW) {
        int r = it;
        if (r < I0) { transpose_item(F.w_in + 1024, INW, F.W1T + (size_t)1024 * 1024, 32, scr, r, F.lane); continue; } r -= I0;
        if (r < I1) { transpose_item(F.w_in + 2560, INW, F.W1T + (size_t)3072 * 1024, 16, scr, r, F.lane); continue; } r -= I1;
        if (r < I1) { transpose_item(F.w_in + 3072, INW, F.W1T + (size_t)3584 * 1024, 16, scr, r, F.lane); continue; } r -= I1;
        if (r < I1) { transpose_item(F.w_in + 3584, INW, F.W1T + (size_t)4096 * 1024, 16, scr, r, F.lane); continue; } r -= I1;
        if (r < I4) { transpose_item(F.w_in + 4096, INW, F.WGT, 96, scr, r, F.lane); continue; } r -= I4;
        if (r < I5) { transpose_item(F.w_pool_out, 1024, F.WPOT, 32, scr, r, F.lane); continue; } r -= I5;
        if (r < I6) { transpose_item(F.w_four_out, 1024, F.WFAT, 32, scr, r, F.lane); continue; } r -= I6;
        if (r < I6) { transpose_item(F.w_attn_out, 1024, F.WFAT + 512, 32, scr, r, F.lane); continue; } r -= I6;
        if (r < I5) { transpose_item(F.w_o, 1024, F.WOT, 32, scr, r, F.lane); continue; } r -= I5;
        transpose_item(F.w_kv, 1024, F.WKVT, 32, scr, r, F.lane);
    }
    for (int m = gw; m < MT + MMEM; m += NGW) {
        if (m < MP) rms_row_to_bf16(F.xp + (size_t)m * DM, F.norm_in, F.XN + (size_t)m * DM, F.lane);
        else if (m < MT) rms_row_to_bf16(F.xs + (size_t)(m - MP) * DM, F.norm_in, F.XN + (size_t)m * DM, F.lane);
        else { const int r = m - MT; const float* src = r < 16 * NMEM ? F.memp + (size_t)r * DM : F.mems + (size_t)(r - 16 * NMEM) * DM; rms_row_to_bf16(src, F.norm_mem, F.MN + (size_t)r * DM, F.lane); }
    }
}

__device__ __forceinline__ void seq_of_row(int row, int& r0, int& S) { if (row < MP) { r0 = row & ~2047; S = 2048; } else { r0 = MP; S = MS; } }
__device__ __forceinline__ void pool_phase(const Ctx& F) {
    const int tid = F.tid, col = 2 * tid, h = 1 << (tid >> 7);
    for (int tile = F.bid; tile < MT / 64; tile += F.G) {
        const int row0 = tile * 64; int r0, S; seq_of_row(row0, r0, S);
        const int t0 = row0 - r0;
        const bf16_t* xb = F.PVF + (size_t)r0 * 1024 + col; bf16_t* gb = F.PA + (size_t)r0 * 1024 + col;
        float s0 = 0.f, s1 = 0.f;
        { const int lo = t0 - h < 0 ? 0 : t0 - h, hi = t0 + h > S ? S : t0 + h;
          for (int i = lo; i < hi; ++i) { const unsigned v = *(const unsigned*)(xb + (size_t)i * 1024); s0 += bflo(v); s1 += bfhi(v); } }
#pragma unroll 4
        for (int t = t0; t < t0 + 64; ++t) {
            const int lo = t - h < 0 ? 0 : t - h, hi = t + h > S ? S : t + h;
            const unsigned me = *(const unsigned*)(xb + (size_t)t * 1024), gt = *(const unsigned*)(gb + (size_t)t * 1024);
            const int ta = t + h < S ? t + h : t, ts = t - h >= 0 ? t - h : t;
            const unsigned va = *(const unsigned*)(xb + (size_t)ta * 1024), vs = *(const unsigned*)(xb + (size_t)ts * 1024);
            const float inv = 1.0f / (float)(hi - lo);
            *(unsigned*)(gb + (size_t)t * 1024) = pk2((s0 * inv - bflo(me)) * bflo(gt), (s1 * inv - bfhi(me)) * bfhi(gt));
            if (t + h < S) { s0 += bflo(va); s1 += bfhi(va); }
            if (t - h >= 0) { s0 -= bflo(vs); s1 -= bfhi(vs); }
        }
    }
}
__device__ __forceinline__ void dft1_phase(const Ctx& F) {
    const LAS f32x2* tab = (const LAS f32x2*)(F.lds + TAB_OFF);
    for (int it = F.bid; it < 16384 + 8192; it += F.G) {
        int seq, s2, head, chk, N1, r0, S, sh;
        if (it < 16384) { seq = it >> 10; const int r = it & 1023; s2 = r >> 3; head = (r >> 1) & 3; chk = r & 1; N1 = 16; r0 = seq * 2048; S = 2048; sh = 3; }
        else { const int r = it - 16384; seq = 16; s2 = r >> 6; head = (r >> 4) & 3; chk = r & 15; N1 = 128; r0 = MP; S = MS; sh = 0; }
        const int k1 = chk * 8 + (F.tid >> 6), col = head * 128 + 2 * (F.tid & 63);
        float yr0 = 0.f, yr1 = 0.f, yi0 = 0.f, yi1 = 0.f;
        for (int s1 = 0; s1 < N1; ++s1) {
            const size_t ro = (size_t)(r0 + 128 * s1 + s2) * 1024 + col;
            const unsigned av = *(const unsigned*)(F.AB + ro), bv = *(const unsigned*)(F.AB + ro + 512);
            const f32x2 cs = tab[((k1 * s1) << sh) & 127];
            const float a0 = bflo(av), a1 = bfhi(av), b0 = bflo(bv), b1 = bfhi(bv);
            yr0 += cs.x * a0 - cs.y * b0; yi0 += cs.y * a0 + cs.x * b0;
            yr1 += cs.x * a1 - cs.y * b1; yi1 += cs.y * a1 + cs.x * b1;
        }
        float tc, ts; { const float ang = 2.0f * (float)(k1 * s2) / (float)S; ts = sinpif(ang); tc = cospif(ang); }
        const float sc = N1 == 16 ? 0.25f : 0.08838834764831845f; tc *= sc; ts *= sc;
        const size_t wo = (size_t)(r0 + 128 * k1 + s2) * 1024 + col;
        *(unsigned*)(F.Y1 + wo) = pk2(yr0 * tc - yi0 * ts, yr1 * tc - yi1 * ts);
        *(unsigned*)(F.Y1 + wo + 512) = pk2(yr0 * ts + yi0 * tc, yr1 * ts + yi1 * tc);
    }
}
__device__ __forceinline__ void dft2_phase(const Ctx& F) {
    const LAS f32x2* tab = (const LAS f32x2*)(F.lds + TAB_OFF);
    for (int it = F.bid; it < 16384 + 8192; it += F.G) {
        int seq, k1, head, chk, N1, r0;
        if (it < 16384) { seq = it >> 10; const int r = it & 1023; k1 = r >> 6; head = (r >> 4) & 3; chk = r & 15; N1 = 16; r0 = seq * 2048; }
        else { const int r = it - 16384; seq = 16; k1 = r >> 6; head = (r >> 4) & 3; chk = r & 15; N1 = 128; r0 = MP; }
        const int k2 = chk * 8 + (F.tid >> 6), col = head * 128 + 2 * (F.tid & 63);
        float f0 = 0.f, f1 = 0.f;
        for (int s2 = 0; s2 < 128; ++s2) {
            const size_t ro = (size_t)(r0 + 128 * k1 + s2) * 1024 + col;
            const unsigned rv = *(const unsigned*)(F.Y1 + ro), iv = *(const unsigned*)(F.Y1 + ro + 512);
            const f32x2 cs = tab[(k2 * s2) & 127];
            f0 += cs.x * bflo(rv) - cs.y * bflo(iv); f1 += cs.x * bfhi(rv) - cs.y * bfhi(iv);
        }
        const size_t wo = (size_t)(r0 + k1 + N1 * k2) * 1024 + col;
        const unsigned gt = *(const unsigned*)(F.FO + wo);
        *(unsigned*)(F.FO + wo) = pk2(f0 * 0.08838834764831845f * bflo(gt), f1 * 0.08838834764831845f * bfhi(gt));
    }
}

namespace dft {
using s16x4 = __attribute__((ext_vector_type(4))) short;
constexpr int ROWB = 288;
template <int OFF> __device__ __forceinline__ s16x4 tr(unsigned a) { s16x4 r; asm volatile("ds_read_b64_tr_b16 %0, %1 offset:%2" : "=&v"(r) : "v"(a), "i"(OFF) : "memory"); return r; }
__device__ __forceinline__ bf16x8 efrag(const bf16_t* E, int ldE, int row, int ks, int G) {
    const bf16_t* p = E + (size_t)row * ldE + 32 * ks + 16 * (G >> 1) + 4 * (G & 1);
    const u32x2 a = *(const u32x2*)p, b = *(const u32x2*)(p + 8);
    u32x4 w; w.x = a.x; w.y = a.y; w.z = b.x; w.w = b.y; return __builtin_bit_cast(bf16x8, w);
}
template <int MT, int KS>
__device__ __forceinline__ void mma(f32x4 (&acc)[MT][8], const bf16x8 (&ef)[MT][KS], unsigned vbase) {
#pragma unroll
    for (int ks = 0; ks < KS; ++ks) {
        const unsigned b = vbase + ks * (32 * ROWB);
        s16x4 lo[8], hi[8];
        lo[0] = tr<0>(b);   hi[0] = tr<8 * ROWB + 0>(b);   lo[1] = tr<32>(b);  hi[1] = tr<8 * ROWB + 32>(b);  lo[2] = tr<64>(b);  hi[2] = tr<8 * ROWB + 64>(b);  lo[3] = tr<96>(b);  hi[3] = tr<8 * ROWB + 96>(b);
        lo[4] = tr<128>(b); hi[4] = tr<8 * ROWB + 128>(b); lo[5] = tr<160>(b); hi[5] = tr<8 * ROWB + 160>(b); lo[6] = tr<192>(b); hi[6] = tr<8 * ROWB + 192>(b); lo[7] = tr<224>(b); hi[7] = tr<8 * ROWB + 224>(b);
        asm volatile("s_waitcnt lgkmcnt(0)" ::: "memory"); __builtin_amdgcn_sched_barrier(0);
#pragma unroll
        for (int nt = 0; nt < 8; ++nt) { const bf16x8 vf = (bf16x8){lo[nt][0], lo[nt][1], lo[nt][2], lo[nt][3], hi[nt][0], hi[nt][1], hi[nt][2], hi[nt][3]};
#pragma unroll
            for (int mt = 0; mt < MT; ++mt) acc[mt][nt] = __builtin_amdgcn_mfma_f32_16x16x32_bf16(vf, ef[mt][ks], acc[mt][nt], 0, 0, 0); }
    }
}
struct Stage { u32x4 v[8]; };
template <int MODE> __device__ __forceinline__ void load(Stage& st, const bf16_t* buf, int r0, int x, int h, int tid) {
#pragma unroll
    for (int i = 0; i < 8; ++i) { const int c = tid + 512 * i, kr = c >> 4, c16 = c & 15; int row, part;
        if (MODE == 0) { row = r0 + 128 * (kr & 127) + x; part = kr >> 7; }
        else if (MODE == 1) { const int kk = kr & 31; row = r0 + 128 * (kk & 15) + x + (kr >> 5); part = kk >> 4; }
        else { row = r0 + 128 * x + (kr & 127); part = kr >> 7; }
        st.v[i] = *(const u32x4*)(buf + (size_t)row * 1024 + part * 512 + h * 128 + c16 * 8); }
}
__device__ __forceinline__ void store_image(const Stage& st, LAS unsigned char* img, int tid) {
#pragma unroll
    for (int i = 0; i < 8; ++i) { const int c = tid + 512 * i; *(LAS u32x4*)(img + (c >> 4) * ROWB + (c & 15) * 16) = st.v[i]; }
}
}
template <int N1>
__device__ __forceinline__ void dft1_mfma(const Ctx& F, const bf16_t* E) {
    constexpr int KS = N1 == 128 ? 8 : 1, MODE = N1 == 128 ? 0 : 1, LDE = 2 * N1;
    const int lane = F.lane, G = lane >> 4, i16 = lane & 15, w = F.wave;
    const int nitems = N1 == 128 ? 128 * 4 : 16 * 16 * 4;
    LAS unsigned char* img = F.lds;
    const unsigned vbase = (unsigned)(uintptr_t)img + (16 * (G >> 1) + 4 * (G & 1) + (i16 >> 2)) * dft::ROWB + 8 * (lane & 3) + (N1 == 128 ? 0 : w * 32 * dft::ROWB);
    const int k1 = (N1 == 128 ? 16 * w : 0) + i16;
    bf16x8 ef[2][KS];
#pragma unroll
    for (int ks = 0; ks < KS; ++ks) { ef[0][ks] = dft::efrag(E, LDE, k1, ks, G); ef[1][ks] = dft::efrag(E, LDE, N1 + k1, ks, G); }
    dft::Stage st;
    int it = F.bid;
    auto decode = [&](int item, int& r0, int& x, int& h) { if (N1 == 128) { r0 = MP; x = item >> 2; h = item & 3; } else { r0 = (item >> 6) * 2048; x = ((item >> 2) & 15) * 8; h = item & 3; } };
    int r0, x, h;
    if (it < nitems) { decode(it, r0, x, h); dft::load<MODE>(st, F.AB, r0, x, h, F.tid); }
    for (; it < nitems; it += F.G) {
        decode(it, r0, x, h);
        __syncthreads();
        dft::store_image(st, img, F.tid);
        __syncthreads();
        { const int nx = it + F.G; if (nx < nitems) { int r0n, xn, hn; decode(nx, r0n, xn, hn); dft::load<MODE>(st, F.AB, r0n, xn, hn, F.tid); } }
        f32x4 acc[2][8];
#pragma unroll
        for (int a = 0; a < 2; ++a)
#pragma unroll
            for (int n = 0; n < 8; ++n) acc[a][n] = (f32x4){0.f, 0.f, 0.f, 0.f};
        dft::mma<2, KS>(acc, ef, vbase);
        const int s2 = N1 == 128 ? x : x + w, S = N1 == 128 ? MS : 2048;
        const float ang = 2.0f * (float)(k1 * s2) / (float)S; const float ts = sinpif(ang), tc = cospif(ang);
        bf16_t* orow = F.AB + (size_t)(r0 + 128 * k1 + s2) * 1024 + h * 128 + 4 * G;
#pragma unroll
        for (int nt = 0; nt < 8; ++nt) { const f32x4 yr = acc[0][nt], yi = acc[1][nt];
            u32x2 re, im;
            re.x = cvt_pk_bf16(yr[0] * tc - yi[0] * ts, yr[1] * tc - yi[1] * ts); re.y = cvt_pk_bf16(yr[2] * tc - yi[2] * ts, yr[3] * tc - yi[3] * ts);
            im.x = cvt_pk_bf16(yr[0] * ts + yi[0] * tc, yr[1] * ts + yi[1] * tc); im.y = cvt_pk_bf16(yr[2] * ts + yi[2] * tc, yr[3] * ts + yi[3] * tc);
            *(u32x2*)(orow + 16 * nt) = re; *(u32x2*)(orow + 512 + 16 * nt) = im; }
    }
    __syncthreads();
}
__device__ __forceinline__ void dft2_mfma(const Ctx& F, const bf16_t* E) {
    const int lane = F.lane, G = lane >> 4, i16 = lane & 15, w = F.wave;
    constexpr int nitems = 16 * 16 * 4 + 128 * 4;
    LAS unsigned char* img = F.lds;
    const unsigned vbase = (unsigned)(uintptr_t)img + (16 * (G >> 1) + 4 * (G & 1) + (i16 >> 2)) * dft::ROWB + 8 * (lane & 3);
    const int k2 = 16 * w + i16;
    bf16x8 ef[1][8];
#pragma unroll
    for (int ks = 0; ks < 8; ++ks) ef[0][ks] = dft::efrag(E, 256, k2, ks, G);
    dft::Stage st;
    int it = F.bid;
    auto decode = [&](int item, int& r0, int& x, int& h, int& N1) { if (item < 1024) { r0 = (item >> 6) * 2048; x = (item >> 2) & 15; h = item & 3; N1 = 16; } else { const int j = item - 1024; r0 = MP; x = j >> 2; h = j & 3; N1 = 128; } };
    int r0, x, h, N1;
    if (it < nitems) { decode(it, r0, x, h, N1); dft::load<2>(st, F.AB, r0, x, h, F.tid); }
    for (; it < nitems; it += F.G) {
        decode(it, r0, x, h, N1);
        __syncthreads();
        dft::store_image(st, img, F.tid);
        __syncthreads();
        { const int nx = it + F.G; if (nx < nitems) { int r0n, xn, hn, nn; decode(nx, r0n, xn, hn, nn); dft::load<2>(st, F.AB, r0n, xn, hn, F.tid); } }
        f32x4 acc[1][8];
#pragma unroll
        for (int n = 0; n < 8; ++n) acc[0][n] = (f32x4){0.f, 0.f, 0.f, 0.f};
        dft::mma<1, 8>(acc, ef, vbase);
        bf16_t* orow = F.FO + (size_t)(r0 + x + N1 * k2) * 1024 + h * 128 + 4 * G;
#pragma unroll
        for (int nt = 0; nt < 8; ++nt) { const f32x4 f = acc[0][nt]; const u32x2 g = *(const u32x2*)(orow + 16 * nt);
            u32x2 o; o.x = cvt_pk_bf16(f[0] * bflo(g.x), f[1] * bfhi(g.x)); o.y = cvt_pk_bf16(f[2] * bflo(g.y), f[3] * bfhi(g.y));
            *(u32x2*)(orow + 16 * nt) = o; }
    }
    __syncthreads();
}
constexpr size_t WS_TAB = 42 * MiB; constexpr int TAB_E116 = 65536, TAB_E2 = 65536 + 1024, TAB_N = 65536 + 1024 + 32768;
__device__ __forceinline__ void build_tables(const Ctx& F, bf16_t* T) {
    for (int idx = F.bid * NTHR + F.tid; idx < TAB_N; idx += F.G * NTHR) {
        float v;
        if (idx < TAB_E116) { const int m = idx >> 8, k = idx & 255, ri = m >> 7, k1 = m & 127, rp = k >> 7, s1 = k & 127; const float a = (float)((k1 * s1) & 127) * (1.0f / 64.0f), c = cospif(a), sn = sinpif(a);
            v = (ri == rp ? c : (ri == 0 ? -sn : sn)) * 0.08838834764831845f; }
        else if (idx < TAB_E2) { const int j = idx - TAB_E116, m = j >> 5, k = j & 31, ri = m >> 4, k1 = m & 15, rp = k >> 4, s1 = k & 15; const float a = (float)((k1 * s1) & 15) * (1.0f / 8.0f), c = cospif(a), sn = sinpif(a);
            v = (ri == rp ? c : (ri == 0 ? -sn : sn)) * 0.25f; }
        else { const int j = idx - TAB_E2, m = j >> 8, k = j & 255, rp = k >> 7, s2 = k & 127; const float a = (float)((m * s2) & 127) * (1.0f / 64.0f);
            v = (rp == 0 ? cospif(a) : -sinpif(a)) * 0.08838834764831845f; }
        T[idx] = (bf16_t)f2bf(v);
    }
}
__device__ __forceinline__ void attn_phase_simple(const Ctx& F) {
    const int gw = F.bid * NWAVES + F.wave, NGW = F.G * NWAVES, lane = F.lane;
    for (int it = gw; it < MT * 4; it += NGW) {
        const int row = it >> 2, h = it & 3, seq = row < MP ? row >> 11 : 16;
        const bf16_t* q = F.Q + (size_t)row * 512 + h * 128;
        const bf16_t* Kb = F.KV + (size_t)(seq * NMEM) * 1024 + h * 128;
        const bf16_t* Vb = Kb + 512;
        float s[4] = {0.f, 0.f, 0.f, 0.f};
        for (int d = 0; d < 128; d += 8) {
            const u32x4 qv = *(const u32x4*)(q + d);
            const float q0 = bflo(qv.x), q1 = bfhi(qv.x), q2 = bflo(qv.y), q3 = bfhi(qv.y), q4 = bflo(qv.z), q5 = bfhi(qv.z), q6 = bflo(qv.w), q7 = bfhi(qv.w);
#pragma unroll
            for (int i = 0; i < 4; ++i) { const u32x4 kv = *(const u32x4*)(Kb + (size_t)(lane + 64 * i) * 1024 + d);
                s[i] += q0 * bflo(kv.x) + q1 * bfhi(kv.x) + q2 * bflo(kv.y) + q3 * bfhi(kv.y) + q4 * bflo(kv.z) + q5 * bfhi(kv.z) + q6 * bflo(kv.w) + q7 * bfhi(kv.w); }
        }
        const float scale = 0.08838834764831845f;
#pragma unroll
        for (int i = 0; i < 4; ++i) s[i] *= scale;
        const float mx = wave_max(fmaxf(fmaxf(s[0], s[1]), fmaxf(s[2], s[3])));
        float p[4], l = 0.f;
#pragma unroll
        for (int i = 0; i < 4; ++i) { p[i] = __expf(s[i] - mx); l += p[i]; }
        l = wave_sum(l);
        float o0 = 0.f, o1 = 0.f;
#pragma unroll
        for (int i = 0; i < 4; ++i)
            for (int kk = 0; kk < 64; ++kk) { const float pk = __shfl(p[i], kk); const unsigned vv = *(const unsigned*)(Vb + (size_t)(64 * i + kk) * 1024 + 2 * lane); o0 += pk * bflo(vv); o1 += pk * bfhi(vv); }
        const float rl = 1.0f / l;
        unsigned* dst = (unsigned*)(F.FO + (size_t)row * 1024 + 512 + h * 128 + 2 * lane);
        const unsigned gt = *dst;
        *dst = pk2(o0 * rl * bflo(gt), o1 * rl * bfhi(gt));
    }
}

namespace att {
using bf16 = unsigned short;
using s16x4  = __attribute__((ext_vector_type(4))) short;
using f32x16 = __attribute__((ext_vector_type(16))) float;
constexpr int D = 128, NW = 8, QBLK = 32, KVBLK = 64;
constexpr float SCALE = 0.088388347648318440f;
constexpr float THR = 8.f;
constexpr int SDEPTH = 2;
constexpr int LDQ = 512, LDK = 1024, LDO = 1024;
constexpr size_t SHM_V = KVBLK * D * 2, SHM_K = KVBLK * D * 2, SHM_ATTN = 2 * SHM_V + 2 * SHM_K + NW * 64 * 4;
#define KSWZ(row, colB) ((row) * 256 + ((colB) ^ (((row) & 7) << 4)))
#define SBAR() __builtin_amdgcn_sched_barrier(0)
__device__ __forceinline__ int crow(int r, int hi) { return (r & 3) + 8 * (r >> 2) + 4 * hi; }
__device__ __forceinline__ unsigned cvtpk(float lo, float hi) { unsigned r; asm volatile("v_cvt_pk_bf16_f32 %0, %1, %2" : "=v"(r) : "v"(lo), "v"(hi)); return r; }
__device__ __forceinline__ bf16x8 ld8(const bf16* p) { return *reinterpret_cast<const bf16x8*>(p); }
__device__ __forceinline__ void partialSM(f32x16& p0, f32x16& p1, float& m_reg, float& mn, float& alpha) {
  constexpr float C = SCALE * 1.4426950408889634f;
  float pmax = p0[0]; for (int r = 1; r < 16; ++r) pmax = fmaxf(pmax, p0[r]); for (int r = 0; r < 16; ++r) pmax = fmaxf(pmax, p1[r]);
  { auto rr = __builtin_amdgcn_permlane32_swap(__float_as_uint(pmax), __float_as_uint(pmax), false, false);
    pmax = fmaxf(__uint_as_float(rr[0]), __uint_as_float(rr[1])); }
  if (__builtin_expect(__all(pmax - m_reg <= THR / SCALE), 1)) { mn = m_reg; alpha = 1.f; }
  else { mn = fmaxf(m_reg, pmax); alpha = __builtin_amdgcn_exp2f((m_reg - mn) * C); m_reg = mn; }
  float mnC = -mn * C;
  for (int r = 0; r < 16; ++r) p0[r] = fmaf(p0[r], C, mnC); for (int r = 0; r < 16; ++r) p1[r] = fmaf(p1[r], C, mnC);
  for (int r = 0; r < 16; ++r) p0[r] = __builtin_amdgcn_exp2f(p0[r]);
}
__device__ __forceinline__ void finishSM(f32x16& p0, f32x16& p1, float alpha, float& l_reg, bf16x8& pa0, bf16x8& pa1, bf16x8& pa2, bf16x8& pa3) {
  for (int r = 0; r < 16; ++r) p1[r] = __builtin_amdgcn_exp2f(p1[r]);
  float ps = 0; for (int r = 0; r < 16; ++r) ps += p0[r]; for (int r = 0; r < 16; ++r) ps += p1[r];
  { auto rr = __builtin_amdgcn_permlane32_swap(__float_as_uint(ps), __float_as_uint(ps), false, false);
    ps = __uint_as_float(rr[0]) + __uint_as_float(rr[1]); }
  l_reg = l_reg * alpha + ps;
#define PK4(P, BASE, OUT) do { unsigned a0 = cvtpk(P[BASE + 0], P[BASE + 1]), a1 = cvtpk(P[BASE + 2], P[BASE + 3]);   \
    unsigned b0 = cvtpk(P[BASE + 4], P[BASE + 5]), b1 = cvtpk(P[BASE + 6], P[BASE + 7]);                              \
    auto r0 = __builtin_amdgcn_permlane32_swap(a0, b0, false, false); auto r1 = __builtin_amdgcn_permlane32_swap(a1, b1, false, false); \
    u32x4 w = {r0[0], r1[0], r0[1], r1[1]}; OUT = *reinterpret_cast<bf16x8*>(&w); } while (0)
  PK4(p0, 0, pa0); PK4(p0, 8, pa1); PK4(p1, 0, pa2); PK4(p1, 8, pa3);
#undef PK4
}
__device__ __forceinline__ void qkt(f32x16& p0, f32x16& p1, const bf16* Ks, const bf16x8* qr, int r32, int hi) {
  p0 = f32x16{}; p1 = f32x16{};
  for (int d0 = 0; d0 < 8; ++d0) { int cb = (d0 * 16 + hi * 8) * 2;
    bf16x8 b0 = *reinterpret_cast<const bf16x8*>((const char*)Ks + KSWZ(r32, cb));
    bf16x8 b1 = *reinterpret_cast<const bf16x8*>((const char*)Ks + KSWZ(32 + r32, cb));
    p0 = __builtin_amdgcn_mfma_f32_32x32x16_bf16(b0, qr[d0], p0, 0, 0, 0);
    p1 = __builtin_amdgcn_mfma_f32_32x32x16_bf16(b1, qr[d0], p1, 0, 0, 0); }
}
__device__ __forceinline__ int v_st(int k, int c) { const int kk = (k & ~0xC) | ((k & 4) << 1) | ((k & 8) >> 1); return ((kk >> 3) * 4 + (c >> 5)) * 512 + ((kk & 7) * 32 + (c & 31)) * 2; }
__device__ __forceinline__ int v_rd_base(int lane) { return ((lane & 3) << 3) | (((lane >> 2) & 3) << 6) | (((lane >> 4) & 1) << 5) | (((lane >> 5) & 1) << 8); }
constexpr int v_rd_off(int d0, int ks, int half) { return d0 * 512 + ks * 4096 + half * 2048; }
template <int OFF> __device__ __forceinline__ s16x4 tr_read(int vb) {
  s16x4 r; asm volatile("ds_read_b64_tr_b16 %0, %1 offset:%2" : "=&v"(r) : "v"(vb), "i"(OFF) : "memory"); return r;
}
template <int D0> __device__ __forceinline__ void pv_one(f32x16& od, int vb, bf16x8 pa0, bf16x8 pa1, bf16x8 pa2, bf16x8 pa3) {
  const s16x4 l0 = tr_read<v_rd_off(D0, 0, 0)>(vb), h0 = tr_read<v_rd_off(D0, 0, 1)>(vb), l1 = tr_read<v_rd_off(D0, 1, 0)>(vb), h1 = tr_read<v_rd_off(D0, 1, 1)>(vb);
  const s16x4 l2 = tr_read<v_rd_off(D0, 2, 0)>(vb), h2 = tr_read<v_rd_off(D0, 2, 1)>(vb), l3 = tr_read<v_rd_off(D0, 3, 0)>(vb), h3 = tr_read<v_rd_off(D0, 3, 1)>(vb);
  asm volatile("s_waitcnt lgkmcnt(0)" ::: "memory"); SBAR();
#define PK(L, H) (bf16x8){L[0], L[1], L[2], L[3], H[0], H[1], H[2], H[3]}
  od = __builtin_amdgcn_mfma_f32_32x32x16_bf16(pa0, PK(l0, h0), od, 0, 0, 0);
  od = __builtin_amdgcn_mfma_f32_32x32x16_bf16(pa1, PK(l1, h1), od, 0, 0, 0);
  od = __builtin_amdgcn_mfma_f32_32x32x16_bf16(pa2, PK(l2, h2), od, 0, 0, 0);
  od = __builtin_amdgcn_mfma_f32_32x32x16_bf16(pa3, PK(l3, h3), od, 0, 0, 0);
#undef PK
}
__device__ __forceinline__ void pv_d0(f32x16* o, int vb, bf16x8 pa0, bf16x8 pa1, bf16x8 pa2, bf16x8 pa3) {
  pv_one<0>(o[0], vb, pa0, pa1, pa2, pa3); pv_one<1>(o[1], vb, pa0, pa1, pa2, pa3); pv_one<2>(o[2], vb, pa0, pa1, pa2, pa3); pv_one<3>(o[3], vb, pa0, pa1, pa2, pa3);
}
__device__ __forceinline__ void attn_unit(const bf16* __restrict__ Qb, const bf16* __restrict__ Kh, const bf16* __restrict__ Vh, bf16* __restrict__ Ob, int seq, char* lds) {
  const int tid = threadIdx.x, wid = tid >> 6, lane = tid & 63, r32 = lane & 31, hi = lane >> 5;
  bf16* V_lds = (bf16*)lds; bf16* K_lds = (bf16*)(lds + 2 * SHM_V);
  float* ws = (float*)(lds + 2 * SHM_V + 2 * SHM_K) + wid * 64; float* li_l = ws; float* al_l = ws + 32;
  float m_reg = -1e30f, l_reg = 0; f32x16 o[4] = {}; bf16x8 qr[8];
  const bf16* Qw = Qb + (long)(wid * QBLK + r32) * LDQ + hi * 8;
#pragma unroll
  for (int d0 = 0; d0 < 8; ++d0) qr[d0] = ld8(Qw + d0 * 16);
  const int sr = tid >> 4, sc = (tid & 15) * 8, vst0 = v_st(sr, sc), vst1 = v_st(32 + sr, sc);
  const int vb0 = (int)(uintptr_t)V_lds + v_rd_base(lane);
  struct { bf16x8 vs0, vs1, ks0, ks1; } sr_[SDEPTH];
#define SLOAD(i, k0) do { sr_[i].vs0 = ld8(&Vh[(long)((k0) + sr) * LDK + sc]); sr_[i].vs1 = ld8(&Vh[(long)((k0) + 32 + sr) * LDK + sc]); \
    sr_[i].ks0 = ld8(&Kh[(long)((k0) + sr) * LDK + sc]); sr_[i].ks1 = ld8(&Kh[(long)((k0) + 32 + sr) * LDK + sc]); } while (0)
#define SWRITE(b, i) do { *(bf16x8*)((char*)V_lds + (b) * SHM_V + vst0) = sr_[i].vs0;          \
    *(bf16x8*)((char*)V_lds + (b) * SHM_V + vst1) = sr_[i].vs1; int kc = sc * 2;               \
    *(bf16x8*)((char*)K_lds + (b) * SHM_K + KSWZ(sr, kc)) = sr_[i].ks0;                       \
    *(bf16x8*)((char*)K_lds + (b) * SHM_K + KSWZ(32 + sr, kc)) = sr_[i].ks1; } while (0)
#define SWAIT() asm volatile("s_waitcnt vmcnt(4)" ::: "memory")
#define RESC(a) do { if (__any((a) < 1.f)) { if (hi == 0) al_l[r32] = (a); asm volatile("s_waitcnt lgkmcnt(0)" ::: "memory"); \
    for (int d = 0; d < 4; ++d) for (int r = 0; r < 16; ++r) o[d][r] *= al_l[crow(r, hi)]; } } while (0)
  f32x16 pA0, pA1, pB0, pB1; float mnA, mnB, alA, alB; bf16x8 pa0, pa1, pa2, pa3; const int NT = seq / KVBLK;
  constexpr int SE = 0, SO = SDEPTH - 1;
  SLOAD(SE, 0); asm volatile("s_waitcnt vmcnt(0)" ::: "memory"); SWRITE(0, SE); __syncthreads();
  qkt(pA0, pA1, K_lds, qr, r32, hi); partialSM(pA0, pA1, m_reg, mnA, alA);
  SLOAD(SO, KVBLK); if (2 < NT) SLOAD(SE, 2 * KVBLK);
  SWAIT(); SWRITE(1, SO); __syncthreads();
  for (int j = 1; j + 1 < NT; j += 2) {
    SBAR(); qkt(pB0, pB1, (bf16*)((char*)K_lds + SHM_K), qr, r32, hi);
    finishSM(pA0, pA1, alA, l_reg, pa0, pa1, pa2, pa3); SBAR();
    SLOAD(SO, (j + SDEPTH) * KVBLK); SBAR();
    pv_d0(o, vb0, pa0, pa1, pa2, pa3); partialSM(pB0, pB1, m_reg, mnB, alB);
    __syncthreads(); SWAIT(); SWRITE(0, SE);
    RESC(alB); __syncthreads();
    SBAR(); qkt(pA0, pA1, K_lds, qr, r32, hi);
    finishSM(pB0, pB1, alB, l_reg, pa0, pa1, pa2, pa3); SBAR();
    if (j + 3 < NT) SLOAD(SE, (j + 1 + SDEPTH) * KVBLK); SBAR();
    pv_d0(o, vb0 + (int)SHM_V, pa0, pa1, pa2, pa3); partialSM(pA0, pA1, m_reg, mnA, alA);
    __syncthreads(); SWAIT(); SWRITE(1, SO);
    RESC(alA); __syncthreads();
  }
  SBAR(); qkt(pB0, pB1, (bf16*)((char*)K_lds + SHM_K), qr, r32, hi);
  finishSM(pA0, pA1, alA, l_reg, pa0, pa1, pa2, pa3); SBAR();
  pv_d0(o, vb0, pa0, pa1, pa2, pa3); partialSM(pB0, pB1, m_reg, mnB, alB);
  __syncthreads(); RESC(alB);
  finishSM(pB0, pB1, alB, l_reg, pa0, pa1, pa2, pa3); SBAR();
  pv_d0(o, vb0 + (int)SHM_V, pa0, pa1, pa2, pa3);
  if (hi == 0) li_l[r32] = l_reg; asm volatile("s_waitcnt lgkmcnt(0)" ::: "memory");
  float rli[16];
#pragma unroll
  for (int r = 0; r < 16; ++r) rli[r] = __builtin_amdgcn_rcpf(li_l[crow(r, hi)]);
  bf16* Ow = Ob + (long)(wid * QBLK) * LDO;
#pragma unroll
  for (int r = 0; r < 16; ++r) { int orow = crow(r, hi);
    for (int d0 = 0; d0 < 4; ++d0) { bf16* p = Ow + (long)orow * LDO + d0 * 32 + r32; const float g = __uint_as_float((unsigned)(*p) << 16); *p = (bf16)f2bf(o[d0][r] * rli[r] * g); } }
  __syncthreads();
#undef SLOAD
#undef SWRITE
#undef SWAIT
#undef RESC
}
#undef KSWZ
#undef SBAR
}
__device__ __forceinline__ void attn_phase_mfma(const Ctx& F, char* ldsg) {
    for (int u = F.bid; u < (MT / 256) * 4; u += F.G) {
        const int rb = u >> 2, h = u & 3, row0 = rb * 256, seq = row0 < MP ? row0 >> 11 : 16;
        const bf16_t* Kh = F.KV + (size_t)(seq * NMEM) * 1024 + h * 128;
        att::attn_unit(F.Q + (size_t)row0 * 512 + h * 128, Kh, Kh + 512, F.FO + (size_t)row0 * 1024 + 512 + h * 128, NMEM, ldsg);
    }
}
__device__ __forceinline__ void final_norm_phase(const Ctx& F) {
    const int gw = F.bid * NWAVES + F.wave, NGW = F.G * NWAVES;
    for (int m = gw; m < MT; m += NGW) {
        f32x4* xr = (f32x4*)(F.out + (size_t)m * DM) + F.lane; const f32x4* gr = (const f32x4*)F.norm_f + F.lane;
        f32x4 v[4]; float s = 0.f;
#pragma unroll
        for (int j = 0; j < 4; ++j) { v[j] = xr[64 * j]; s += (v[j].x * v[j].x + v[j].y * v[j].y) + (v[j].z * v[j].z + v[j].w * v[j].w); }
        const float r = 1.0f / sqrtf(wave_sum(s) * (1.f / DM) + EPS);
#pragma unroll
        for (int j = 0; j < 4; ++j) { const f32x4 g = gr[64 * j]; xr[64 * j] = v[j] * r * g; }
    }
}

struct Args { const float* in[17]; float* out; unsigned char* ws; int ph_lo, ph_hi; };
constexpr int N_PHASES = 7;
__global__ void __launch_bounds__(NTHR, 2) fwd(Args args) {
    extern __shared__ __attribute__((aligned(16))) unsigned char lds_[];
    cg::grid_group grid = cg::this_grid();
    Ctx F;
    F.lds = (LAS unsigned char*)lds_;
    F.tid = threadIdx.x; F.lane = F.tid & 63; F.wave = __builtin_amdgcn_readfirstlane(F.tid >> 6); F.G = gridDim.x; F.bid = blockIdx.x;
    F.xp = args.in[0]; F.xs = args.in[1]; F.memp = args.in[2]; F.mems = args.in[3]; F.norm_in = args.in[4]; F.norm_mem = args.in[5]; F.w_in = args.in[6]; F.w_pool_grp = args.in[7];
    F.pool_scale = args.in[8]; F.w_four_grp = args.in[9]; F.w_kv = args.in[10]; F.w_pool_out = args.in[11]; F.w_four_out = args.in[12]; F.w_attn_out = args.in[13]; F.b_gate = args.in[14];
    F.w_o = args.in[15]; F.norm_f = args.in[16]; F.out = args.out;
    unsigned char* ws = args.ws; unsigned char* ob = (unsigned char*)args.out;
    F.W1T = (bf16_t*)(ws + WS_W1T); F.WGT = (bf16_t*)(ws + WS_WGT); F.WPOT = (bf16_t*)(ws + WS_WPOT); F.WFAT = (bf16_t*)(ws + WS_WFAT); F.WOT = (bf16_t*)(ws + WS_WOT); F.WKVT = (bf16_t*)(ws + WS_WKVT);
    F.MN = (bf16_t*)(ws + WS_MN); F.KV = (bf16_t*)(ws + WS_KV); F.XN = (bf16_t*)(ws + WS_XN); F.PA = (bf16_t*)(ws + WS_PA); F.FO = (bf16_t*)(ws + WS_FO); F.AB = (bf16_t*)(ws + WS_AB);
    F.Q = (bf16_t*)(ws + WS_Q); F.PVF = (bf16_t*)(ob + OUT_PVF); F.Y1 = (bf16_t*)(ob + OUT_Y1); F.MERGED = (bf16_t*)(ws + WS_AB);
    F.TAB = (bf16_t*)(ws + WS_TAB);
    F.stash = ob + OUT_STASH + (size_t)blockIdx.x * 262144;
    if (F.tid < 128) { LAS f32x2* tab = (LAS f32x2*)(F.lds + TAB_OFF); f32x2 v; v.x = cospif((float)F.tid * (1.0f / 64.0f)); v.y = sinpif((float)F.tid * (1.0f / 64.0f)); tab[F.tid] = v; }
    if (F.tid < 64) ((LAS unsigned*)(F.lds + MISC_OFF))[F.tid] = 0u;
    __syncthreads();
    XcdBarrier bar = xcd_barrier_post((unsigned*)(ws + WS_CTL), (volatile LAS unsigned*)(F.lds + MISC_OFF) + 8);
    const int lo = args.ph_lo, hi = args.ph_hi;
#define IN(k) (lo <= (k) && (k) < hi)
#define SEAM(k) do { if (IN(k) && IN((k) + 1)) { if ((k) == 0) grid.sync(); else xcd_barrier(bar); } } while (0)
    if (IN(0)) { for (int rep = 0; rep < REP_P0; ++rep) p0_prologue(F); }
    SEAM(0);
    if (IN(1)) {
        SchedP1 S{F.G, F.bid, (const char*)F.XN, (const char*)F.W1T, (const char*)F.MN, (const char*)F.WKVT};
        EpiP1 E{F.PVF, F.PA, F.AB, F.FO, F.Q, F.KV};
        for (int rep = 0; rep < REP_G; ++rep) pg8::gemm_phase<EpiP1, SchedP1, true, true>(F.lds, S, E);
    }
    SEAM(1);
    if (IN(2)) { pool_phase(F); dft1_mfma<128>(F, F.TAB); dft1_mfma<16>(F, F.TAB + TAB_E116); attn_phase_mfma(F, (char*)lds_); }
    SEAM(2);
    if (IN(3)) { dft2_mfma(F, F.TAB + TAB_E2); }
    SEAM(3);
    if (IN(4)) {
        SchedP3 S{F.G, F.bid, (const char*)F.PA, (const char*)F.XN, (const char*)F.FO, (const char*)F.WPOT, (const char*)F.WGT, (const char*)F.WFAT};
        EpiP3 E{F.stash, F.b_gate, F.MERGED};
        for (int rep = 0; rep < REP_G; ++rep) pg8::gemm_phase<EpiP3, SchedP3, true, true>(F.lds, S, E);
    }
    SEAM(4);
    if (IN(5)) {
        SchedP4 S{F.G, F.bid, (const char*)F.MERGED, (const char*)F.WOT};
        EpiP4 E{F.xp, F.xs, F.out};
        for (int rep = 0; rep < REP_G; ++rep) pg8::gemm_phase<EpiP4, SchedP4, true, true>(F.lds, S, E);
    }
    SEAM(5);
    if (IN(6)) { final_norm_phase(F); }
#undef IN
#undef SEAM
}

extern "C" void kernel_launch(void* const* d_in, const int* in_sizes, int n_in, void* d_out, int out_size, void* d_ws, size_t ws_size, hipStream_t stream) {
    static int grid = 0;
    if (grid == 0) {
        if (n_in != 17 || in_sizes[0] != MP * DM || in_sizes[1] != MS * DM || out_size != MT * DM || ws_size < WS_END) {
            fprintf(stderr, "kernel_launch: unexpected shapes: n_in %d in0 %d in1 %d out %d ws %zu (need %zu); nothing launched\n", n_in, n_in > 0 ? in_sizes[0] : -1, n_in > 1 ? in_sizes[1] : -1, out_size, ws_size, (size_t)WS_END);
            grid = -1; return; }
        int dev = 0, cus = 0, per_cu = 0;
        if (hipGetDevice(&dev) != hipSuccess || hipDeviceGetAttribute(&cus, hipDeviceAttributeMultiprocessorCount, dev) != hipSuccess) { grid = -1; return; }
        if (hipFuncSetAttribute((const void*)fwd, hipFuncAttributeMaxDynamicSharedMemorySize, LDS_BYTES) != hipSuccess) { fprintf(stderr, "kernel_launch: hipFuncSetAttribute failed\n"); grid = -1; return; }
        if (hipOccupancyMaxActiveBlocksPerMultiprocessor(&per_cu, (const void*)fwd, NTHR, LDS_BYTES) != hipSuccess || per_cu < 1) { fprintf(stderr, "kernel_launch: occupancy query says %d\n", per_cu); per_cu = 1; }
        (void)hipGetLastError();
        grid = cus;
        if (grid > 256) grid = 256;
    }
    if (grid < 0) return;
    if (hipMemsetAsync((char*)d_ws + WS_CTL, 0, CTL_ZERO_BYTES, stream) != hipSuccess) { fprintf(stderr, "kernel_launch: memset failed\n"); return; }
    Args a{};
    for (int i = 0; i < 17; ++i) a.in[i] = (const float*)d_in[i];
    a.out = (float*)d_out; a.ws = (unsigned char*)d_ws;
#if MK_FUSED
    a.ph_lo = 0; a.ph_hi = N_PHASES;
    void* kargs[] = {&a};
    hipError_t e = hipLaunchCooperativeKernel((const void*)fwd, dim3(grid), dim3(NTHR), kargs, LDS_BYTES, stream);
    if (e != hipSuccess) fprintf(stderr, "kernel_launch: cooperative launch failed: %s (grid %d)\n", hipGetErrorString(e), grid);
#else
    for (int p = 0; p < N_PHASES; ++p) {
        a.ph_lo = p; a.ph_hi = p + 1;
        hipLaunchKernelGGL(fwd, dim3(grid), dim3(NTHR), LDS_BYTES, stream, a);
        const hipError_t le = hipPeekAtLastError();
        if (le != hipSuccess) { fprintf(stderr, "kernel_launch: launch %d failed: %s\n", p, hipGetErrorName(le)); break; }
    }
#endif
}
```

```cpp
#include <hip/hip_runtime.h>
#include <hip/hip_cooperative_groups.h>
#include <cstdio>
#include <cstdint>
namespace cg = cooperative_groups;

#ifndef MK_FUSED
#define MK_FUSED 1
#endif

#ifndef REP_P0
#define REP_P0 1
#endif
#ifndef REP_G
#define REP_G 1
#endif
#define LAS __attribute__((address_space(3)))
typedef unsigned short bf16_t;
typedef short bf16x8 __attribute__((ext_vector_type(8)));
typedef float f32x4 __attribute__((ext_vector_type(4)));
typedef float f32x2 __attribute__((ext_vector_type(2)));
typedef unsigned u32x4 __attribute__((ext_vector_type(4)));
typedef unsigned u32x2 __attribute__((ext_vector_type(2)));

constexpr int DM = 1024;
constexpr int MP = 16 * 2048, MS = 16384, MT = MP + MS;
constexpr int NSEQ = 17, NMEM = 256, MMEM = NSEQ * NMEM;
constexpr int INW = 7168;
constexpr float EPS = 1e-6f;
constexpr int NTHR = 512, NWAVES = 8;

constexpr size_t MiB = 1u << 20;
constexpr size_t WS_CTL = 0, CTL_ZERO_BYTES = 65536;
constexpr int CW_CNT = 4096;
constexpr size_t WS_SLOTS = 44 * MiB;
constexpr size_t WS_W1T = 1 * MiB;
constexpr size_t WS_WGT = 10 * MiB;
constexpr size_t WS_WPOT = 16 * MiB, WS_WFAT = 18 * MiB, WS_WOT = 20 * MiB, WS_WKVT = 22 * MiB;
constexpr size_t WS_MN = 24 * MiB;
constexpr size_t WS_KV = 33 * MiB;
constexpr size_t WS_XN = 48 * MiB;
constexpr size_t WS_PA = 144 * MiB;
constexpr size_t WS_FO = 240 * MiB;
constexpr size_t WS_AB = 336 * MiB;
constexpr size_t WS_Q = 432 * MiB;
constexpr size_t WS_END = 480 * MiB;
constexpr size_t OUT_PVF = 0, OUT_Y1 = 96 * MiB, OUT_STASH = 0;

constexpr int RING_BYTES = 131072;
constexpr int MISC_OFF = RING_BYTES;
constexpr int TAB_OFF = RING_BYTES + 1024;
constexpr int LDS_BYTES = 147456;

__device__ __forceinline__ unsigned f2bf(float f) { unsigned u = __builtin_bit_cast(unsigned, f); return (u + 0x7fffu + ((u >> 16) & 1u)) >> 16; }
__device__ __forceinline__ unsigned pk2(float lo, float hi) { return f2bf(lo) | (f2bf(hi) << 16); }
__device__ __forceinline__ float bflo(unsigned u) { return __builtin_bit_cast(float, u << 16); }
__device__ __forceinline__ float bfhi(unsigned u) { return __builtin_bit_cast(float, u & 0xffff0000u); }
__device__ __forceinline__ unsigned cvt_pk_bf16(float lo, float hi) { unsigned r; asm volatile("v_cvt_pk_bf16_f32 %0, %1, %2" : "=v"(r) : "v"(lo), "v"(hi)); return r; }
__device__ __forceinline__ float sigmoid_f(float v) { return __builtin_amdgcn_rcpf(1.0f + __expf(-v)); }
__device__ __forceinline__ float silu_f(float v) { return v * sigmoid_f(v); }
__device__ __forceinline__ float wave_sum(float v) {
#pragma unroll
    for (int o = 1; o < 64; o <<= 1) v += __shfl_xor(v, o);
    return v;
}
__device__ __forceinline__ float wave_max(float v) {
#pragma unroll
    for (int o = 1; o < 64; o <<= 1) v = fmaxf(v, __shfl_xor(v, o));
    return v;
}
#define LDS_WAIT() asm volatile("s_waitcnt lgkmcnt(0)" ::: "memory")

namespace pg8 {
constexpr int BM = 256, BK = 64, HALF = 128, HTB = HALF * BK * 2, STAGE_BYTES = 8 * HTB, NXCD = 8, WGM = 8;
constexpr int KP = 1024;
constexpr size_t TSTEP = (size_t)BM * KP * 2;
__device__ __forceinline__ int lds_byte(int r, int c) { const int st = (r >> 4) * 2 + (c >> 5), rr = r & 15, cc = c & 31, ob = rr * 64 + cc * 2; return st * 1024 + (ob ^ (((ob >> 9) & 1) << 5)); }
__device__ __forceinline__ void stage_rc(int b, int& R, int& C) { const int st = b / 1024, sb = b % 1024, swz = sb ^ (((sb >> 9) & 1) << 5); R = (st >> 1) * 16 + swz / 64; C = (st & 1) * 32 + (swz % 64) / 2; }
__device__ __forceinline__ int perm32(int rho) { const int n = rho >> 4, i = rho & 15; return 8 * (i >> 2) + 4 * n + (i & 3); }

struct Unit { const char* A; const char* B; int nt, pm, pn, seg; };

__device__ __forceinline__ void tile_order(int L, int nM, int nN, int& pm, int& pn) {
    const int nwg = nM * nN; int wgid = L;
    { const int q = nwg / NXCD, r = nwg % NXCD, xcd = wgid % NXCD, off = wgid / NXCD; wgid = (xcd < r ? xcd * (q + 1) : r * (q + 1) + (xcd - r) * q) + off; }
    const int nig = WGM * nN, gid = wgid / nig, fm = gid * WGM, gsz = (nM - fm) < WGM ? (nM - fm) : WGM;
    pm = fm + ((wgid % nig) % gsz); pn = (wgid % nig) / gsz;
}

template <class Epi, class Sched, bool ALIGN_EPI, bool SP2>
__device__ __forceinline__ void gemm_phase(LAS unsigned char* lds, const Sched& S, const Epi& E) {
    const int tid = threadIdx.x, wid = __builtin_amdgcn_readfirstlane(tid >> 6), lane = tid & 63, wr = wid >> 2, wc = wid & 3, fr = lane & 15, fq = lane >> 4;
    unsigned voffA[2], voffB[2];
#pragma unroll
    for (int i = 0; i < 2; ++i) { int R, C; stage_rc(tid * 16 + i * 8192, R, C); const int Rb = Epi::PERM ? ((R & ~31) + perm32(R & 31)) : R;
        voffA[i] = (unsigned)(R * KP + C) * 2u; voffB[i] = (unsigned)(Rb * KP + C) * 2u; }
    const size_t kstep = (size_t)(BK * 2);
    const size_t hstep = (size_t)HALF * KP * 2;
    const unsigned ldsw = (unsigned)wid * 1024u;
    const int aoff = lds_byte(wr * 64 + fr, fq * 8), boff = lds_byte(wc * 32 + fr, fq * 8);
#define PG8_SA(b, h) (((b) * 2 + (h)) * HTB)
#define PG8_SB(b, h) ((4 + (b) * 2 + (h)) * HTB)
#define PG8_STAGE(bufoff, gbase, voff) do { _Pragma("unroll") for (int _i = 0; _i < 2; ++_i) \
        __builtin_amdgcn_global_load_lds((const unsigned*)((const char*)(gbase) + (voff)[_i]), (LAS unsigned*)(lds + (bufoff) + ldsw + _i * 8192), 16, 0, 0); } while (0)
#define PG8_LDA(dst, b, h) do { _Pragma("unroll") for (int m = 0; m < 4; ++m) _Pragma("unroll") for (int k = 0; k < 2; ++k) dst[m][k] = *(const LAS bf16x8*)(lds + PG8_SA(b, h) + aoff + m * 2048 + k * 1024); } while (0)
#define PG8_LDB(dst, b, h) do { _Pragma("unroll") for (int n = 0; n < 2; ++n) _Pragma("unroll") for (int k = 0; k < 2; ++k) dst[n][k] = *(const LAS bf16x8*)(lds + PG8_SB(b, h) + boff + n * 2048 + k * 1024); } while (0)
#define PG8_MMA(ai, bj, At, Bt) do { __builtin_amdgcn_s_setprio(1); _Pragma("unroll") for (int m = 0; m < 4; ++m) _Pragma("unroll") for (int n = 0; n < 2; ++n) _Pragma("unroll") for (int k = 0; k < 2; ++k) \
        acc[ai][bj][m][n] = __builtin_amdgcn_mfma_f32_16x16x32_bf16(Bt[n][k], At[m][k], acc[ai][bj][m][n], 0, 0, 0); __builtin_amdgcn_s_setprio(0); } while (0)
#define PG8_WAIT_V(n) asm volatile("s_waitcnt vmcnt(" #n ")" ::: "memory")
#define PG8_WAIT_L(n) asm volatile("s_waitcnt lgkmcnt(" #n ")" ::: "memory")
#define PG8_BAR __builtin_amdgcn_s_barrier()
#define PG8_SCHED __builtin_amdgcn_sched_barrier(0)
    Unit cur, nxt; int ui = 0;
    if (!S.next(0, cur)) return;
    f32x4 acc[2][2][4][2];
    E.init(acc, cur, wr, wc, fr, fq);
    bf16x8 At[4][2], B0[2][2], B1[2][2];
    const char* cA = cur.A; const char* cB = cur.B;
    if constexpr (SP2) {
        PG8_STAGE(PG8_SB(0, 0), cB, voffB); PG8_STAGE(PG8_SB(0, 1), cB + hstep, voffB); PG8_STAGE(PG8_SA(0, 0), cA, voffA); PG8_STAGE(PG8_SA(0, 1), cA + hstep, voffA);
        if (wr == 1) PG8_BAR;
        PG8_WAIT_V(2); PG8_BAR;
        PG8_STAGE(PG8_SB(1, 0), cB + kstep, voffB); PG8_STAGE(PG8_SA(1, 0), cA + kstep, voffA); PG8_STAGE(PG8_SB(1, 1), cB + hstep + kstep, voffB);
        PG8_WAIT_V(6); PG8_BAR;
    } else {
        PG8_STAGE(PG8_SB(0, 0), cB, voffB); PG8_STAGE(PG8_SA(0, 0), cA, voffA); PG8_STAGE(PG8_SB(0, 1), cB + hstep, voffB); PG8_STAGE(PG8_SA(0, 1), cA + hstep, voffA);
        if (wr == 1) PG8_BAR;
        PG8_WAIT_V(4); PG8_BAR;
        PG8_STAGE(PG8_SB(1, 0), cB + kstep, voffB); PG8_STAGE(PG8_SA(1, 0), cA + kstep, voffA); PG8_STAGE(PG8_SB(1, 1), cB + hstep + kstep, voffB);
        PG8_WAIT_V(6); PG8_BAR;
    }
    for (;;) {
        const bool has_next = S.next(ui + 1, nxt);
        const char* nA = has_next ? nxt.A : cA; const char* nB = has_next ? nxt.B : cB;
        const int nt = cur.nt;
        for (int t = 0; t < nt; t += 2) {
            const bool last = (t == nt - 2);
            const char* a1 = cA + (size_t)(t + 1) * kstep;
            const char* a2 = last ? nA : cA + (size_t)(t + 2) * kstep; const char* b2 = last ? nB : cB + (size_t)(t + 2) * kstep;
            const char* a3 = a2 + kstep; const char* b3 = b2 + kstep;
            if constexpr (SP2) {
            PG8_LDB(B0, 0, 0); PG8_LDB(B1, 0, 1); PG8_SCHED; PG8_LDA(At, 0, 0); PG8_STAGE(PG8_SA(1, 1), a1 + hstep, voffA);
            PG8_WAIT_V(8); PG8_WAIT_L(0); PG8_BAR; PG8_MMA(0, 0, At, B0); PG8_MMA(0, 1, At, B1); PG8_BAR; PG8_SCHED;
            PG8_LDA(At, 0, 1); PG8_STAGE(PG8_SB(0, 0), b2, voffB); PG8_STAGE(PG8_SB(0, 1), b2 + hstep, voffB); PG8_STAGE(PG8_SA(0, 0), a2, voffA);
            PG8_WAIT_V(8); PG8_WAIT_L(0); PG8_BAR; PG8_MMA(1, 0, At, B0); PG8_MMA(1, 1, At, B1); PG8_BAR; PG8_SCHED;
            PG8_LDB(B0, 1, 0); PG8_LDB(B1, 1, 1); PG8_SCHED; PG8_LDA(At, 1, 0); PG8_STAGE(PG8_SA(0, 1), a2 + hstep, voffA);
            PG8_WAIT_V(8); PG8_WAIT_L(0); PG8_BAR; PG8_MMA(0, 0, At, B0); PG8_MMA(0, 1, At, B1); PG8_BAR; PG8_SCHED;
            PG8_LDA(At, 1, 1); PG8_STAGE(PG8_SB(1, 0), b3, voffB); PG8_STAGE(PG8_SB(1, 1), b3 + hstep, voffB); PG8_STAGE(PG8_SA(1, 0), a3, voffA);
            PG8_WAIT_V(8); PG8_WAIT_L(0); PG8_BAR; PG8_MMA(1, 0, At, B0); PG8_MMA(1, 1, At, B1); PG8_BAR; PG8_SCHED;
            } else {
            PG8_LDB(B0, 0, 0); PG8_SCHED; PG8_LDA(At, 0, 0); PG8_STAGE(PG8_SA(1, 1), a1 + hstep, voffA);
            PG8_WAIT_L(8); PG8_BAR; PG8_WAIT_L(0); PG8_MMA(0, 0, At, B0); PG8_BAR; PG8_SCHED;
            PG8_LDB(B1, 0, 1); PG8_STAGE(PG8_SB(0, 0), b2, voffB);
            PG8_BAR; PG8_WAIT_L(0); PG8_MMA(0, 1, At, B1); PG8_BAR;
            PG8_LDA(At, 0, 1); PG8_STAGE(PG8_SA(0, 0), a2, voffA);
            PG8_BAR; PG8_WAIT_L(0); PG8_MMA(1, 0, At, B0); PG8_BAR; PG8_SCHED;
            PG8_STAGE(PG8_SB(0, 1), b2 + hstep, voffB);
            PG8_WAIT_V(6); PG8_BAR; PG8_MMA(1, 1, At, B1); PG8_BAR;
            PG8_LDB(B0, 1, 0); PG8_SCHED; PG8_LDA(At, 1, 0); PG8_STAGE(PG8_SA(0, 1), a2 + hstep, voffA);
            PG8_WAIT_L(8); PG8_BAR; PG8_WAIT_L(0); PG8_MMA(0, 0, At, B0); PG8_BAR; PG8_SCHED;
            PG8_LDB(B1, 1, 1); PG8_STAGE(PG8_SB(1, 0), b3, voffB);
            PG8_BAR; PG8_WAIT_L(0); PG8_MMA(0, 1, At, B1); PG8_BAR;
            PG8_LDA(At, 1, 1); PG8_STAGE(PG8_SA(1, 0), a3, voffA);
            PG8_BAR; PG8_WAIT_L(0); PG8_MMA(1, 0, At, B0); PG8_BAR; PG8_SCHED;
            PG8_STAGE(PG8_SB(1, 1), b3 + hstep, voffB);
            PG8_WAIT_V(6); PG8_BAR; PG8_MMA(1, 1, At, B1); PG8_BAR;
            }
        }
        if constexpr (ALIGN_EPI) { if (wr == 0) PG8_BAR; }
        E(acc, cur, wr, wc, fr, fq);
        if (!has_next) break;
        cur = nxt; cA = nA; cB = nB; ++ui;
        E.init(acc, cur, wr, wc, fr, fq);
        if constexpr (ALIGN_EPI) { if (wr == 1) PG8_BAR; }
    }
    PG8_WAIT_V(0);
    if constexpr (!ALIGN_EPI) { if (wr == 0) PG8_BAR; }
    PG8_BAR;
#undef PG8_SA
#undef PG8_SB
#undef PG8_STAGE
#undef PG8_LDA
#undef PG8_LDB
#undef PG8_MMA
#undef PG8_WAIT_V
#undef PG8_WAIT_L
#undef PG8_BAR
#undef PG8_SCHED
}
}
using pg8::Unit;


#define XB_TMO      128
#define XB_XCNT(j)  (256  + 64 * (j))
#define XB_XSUB(j)  (1280 + 64 * (j))
#define XB_XGEN(j)  (2304 + 64 * (j))
#define XB_TOP      3328
#define XB_TOPGEN   3392
#define XCD_BAR_WORDS 3456
#define XB_SPIN_CAP (1u << 18)
__device__ __forceinline__ unsigned xb_ld(unsigned* p)              { return __hip_atomic_load(p, __ATOMIC_RELAXED, __HIP_MEMORY_SCOPE_AGENT); }
__device__ __forceinline__ unsigned xb_add(unsigned* p, unsigned v) { return __hip_atomic_fetch_add(p, v, __ATOMIC_RELAXED, __HIP_MEMORY_SCOPE_AGENT); }
__device__ __forceinline__ unsigned xb_xcc_id() { return (unsigned)__builtin_amdgcn_s_getreg((3 << 11) | 20) & 0xFu; }
#define XB_SPIN(cond, bar) do { unsigned _sp = 0; while (cond) { __builtin_amdgcn_s_sleep(1); \
    if ((++_sp & 255u) == 0u) { if (xb_ld(&(bar)[XB_TMO])) break; if (_sp > XB_SPIN_CAP) { atomicAdd(&(bar)[XB_TMO], 1u); break; } } } } while (0)
struct XcdBarrier { unsigned* bar; unsigned x; volatile LAS unsigned* st; };
__device__ __forceinline__ XcdBarrier xcd_barrier_post(unsigned* bar, volatile LAS unsigned* st) {
    XcdBarrier b; b.bar = bar; b.x = xb_xcc_id(); b.st = st;
    if (threadIdx.x == 0) (void)xb_add(&bar[XB_XCNT(b.x)], 1u);
    return b;
}
__device__ __forceinline__ void xcd_barrier_complete(unsigned* bar, unsigned x, unsigned& nloc, unsigned& nx) {
    const unsigned G = gridDim.x * gridDim.y * gridDim.z;
    unsigned sum, cnt, mine, sp = 0u;
    for (;;) {
        sum = 0u; cnt = 0u; mine = 0u;
#pragma unroll
        for (unsigned j = 0; j < 16; ++j) { const unsigned c = xb_ld(&bar[XB_XCNT(j)]); sum += c; cnt += (c > 0u) ? 1u : 0u; mine = (j == x) ? c : mine; }
        if (sum == G) break;
        __builtin_amdgcn_s_sleep(1);
        if ((++sp & 255u) == 0u) { if (xb_ld(&bar[XB_TMO])) break; if (sp > XB_SPIN_CAP) { atomicAdd(&bar[XB_TMO], 1u); break; } }
    }
    nloc = mine > 0u ? mine : 1u; nx = cnt > 0u ? cnt : 1u;
}
__device__ __forceinline__ void xcd_barrier(const XcdBarrier& b) {
    asm volatile("s_waitcnt vmcnt(0)" ::: "memory");
    __syncthreads();
    if (threadIdx.x == 0) {
        unsigned* bar = b.bar;
        __builtin_amdgcn_s_waitcnt(0);
        unsigned nloc = b.st[0], nx = b.st[1];
        if (nloc == 0u) { xcd_barrier_complete(bar, b.x, nloc, nx); b.st[0] = nloc; b.st[1] = nx; }
        const unsigned old = xb_add(&bar[XB_XSUB(b.x)], 1u);
        const unsigned gen = old / nloc;
        if (old + 1u == (gen + 1u) * nloc) {
            __builtin_amdgcn_fence(__ATOMIC_RELEASE, "agent");
            asm volatile("s_waitcnt vmcnt(0)" ::: "memory");
            const unsigned og = xb_add(&bar[XB_TOP], 1u);
            const unsigned tg = og / nx;
            if (og + 1u == (tg + 1u) * nx) xb_add(&bar[XB_TOPGEN], 1u);
            else XB_SPIN(xb_ld(&bar[XB_TOPGEN]) == tg, bar);
            __builtin_amdgcn_fence(__ATOMIC_ACQUIRE, "agent");
            xb_add(&bar[XB_XGEN(b.x)], 1u);
            asm volatile("s_waitcnt vmcnt(0)" ::: "memory");
        } else {
            XB_SPIN(xb_ld(&bar[XB_XGEN(b.x)]) == gen, bar);
            __builtin_amdgcn_fence(__ATOMIC_ACQUIRE, "agent");
            asm volatile("s_waitcnt vmcnt(0)" ::: "memory");
        }
    }
    __syncthreads();
}
struct Ctx {
    LAS unsigned char* lds;
    int tid, lane, wave, G, bid;
    const float *xp, *xs, *memp, *mems, *norm_in, *norm_mem, *w_in, *w_pool_grp, *pool_scale, *w_four_grp, *w_kv, *w_pool_out, *w_four_out, *w_attn_out, *b_gate, *w_o, *norm_f;
    float* out;
    bf16_t *W1T, *WGT, *WPOT, *WFAT, *WOT, *WKVT, *MN, *KV, *XN, *PA, *FO, *AB, *Q, *PVF, *Y1, *MERGED, *TAB;
    unsigned char* stash;
};

struct SchedP1 {
    int G, c; const char *XN, *W1T, *MN, *WKVT;
    __device__ __forceinline__ bool next(int i, Unit& u) const {
        int L = i * G + c; u.nt = 16;
        if (L < 192 * 18) { pg8::tile_order(L, 192, 18, u.pm, u.pn); u.A = XN + (size_t)u.pm * pg8::TSTEP; u.B = W1T + (size_t)u.pn * pg8::TSTEP; u.seg = 0; return true; }
        L -= 192 * 18; if (L >= 17 * 4) return false;
        u.pm = L % 17; u.pn = L / 17; u.A = MN + (size_t)u.pm * pg8::TSTEP; u.B = WKVT + (size_t)u.pn * pg8::TSTEP; u.seg = 1; return true;
    }
};
struct EpiP1 {
    static constexpr bool PERM = true;
    __device__ __forceinline__ void init(f32x4 (&acc)[2][2][4][2], const Unit&, int, int, int, int) const {
#pragma unroll
        for (int a = 0; a < 2; ++a)
#pragma unroll
            for (int b = 0; b < 2; ++b)
#pragma unroll
                for (int m = 0; m < 4; ++m)
#pragma unroll
                    for (int n = 0; n < 2; ++n) acc[a][b][m][n] = (f32x4){0.f, 0.f, 0.f, 0.f};
    }
    bf16_t *PVF, *SPG, *AB, *FO, *Q, *KV;
    __device__ __forceinline__ void operator()(const f32x4 (&acc)[2][2][4][2], const Unit& u, int wr, int wc, int fr, int fq) const {
        bf16_t* base; int ld, colt, act; const int pn = u.pn;
        if (u.seg == 1) { base = KV; ld = 1024; colt = pn * 256; act = 0; }
        else if (pn < 4) { base = PVF; ld = 1024; colt = pn * 256; act = 0; }
        else if (pn < 8) { base = SPG; ld = 1024; colt = (pn - 4) * 256; act = 1; }
        else if (pn < 12) { base = AB; ld = 1024; colt = (pn - 8) * 256; act = 0; }
        else if (pn < 14) { base = FO; ld = 1024; colt = (pn - 12) * 256; act = 1; }
        else if (pn < 16) { base = Q; ld = 512; colt = (pn - 14) * 256; act = 0; }
        else { base = FO; ld = 1024; colt = 512 + (pn - 16) * 256; act = 1; }
        const int row0 = u.pm * 256 + wr * 64 + fr, col0 = colt + wc * 32 + 8 * fq;
        const bool tr = (u.seg == 0) && (pn >= 8) && (pn < 12) && (u.pm >= MP / 256);
#pragma unroll
        for (int ai = 0; ai < 2; ++ai)
#pragma unroll
            for (int m = 0; m < 4; ++m) { int orow = row0 + ai * 128 + m * 16;
                if (tr) { const int t = orow - MP; orow = MP + 128 * (t & 127) + (t >> 7); }
                bf16_t* rowp = base + (size_t)orow * ld + col0;
#pragma unroll
                for (int bj = 0; bj < 2; ++bj) { f32x4 v0 = acc[ai][bj][m][0], v1 = acc[ai][bj][m][1];
                    if (act) {
#pragma unroll
                        for (int j = 0; j < 4; ++j) { v0[j] = silu_f(v0[j]); v1[j] = silu_f(v1[j]); } }
                    u32x4 w; w.x = cvt_pk_bf16(v0[0], v0[1]); w.y = cvt_pk_bf16(v0[2], v0[3]); w.z = cvt_pk_bf16(v1[0], v1[1]); w.w = cvt_pk_bf16(v1[2], v1[3]);
                    *(u32x4*)(rowp + bj * 128) = w; } }
    }
};
struct SchedP3 {
    int G, c; const char *PA, *XN, *FO, *WPOT, *WGT, *WFAT;
    __device__ __forceinline__ bool next(int i, Unit& u) const {
        const int ti = i / 6, seg = i - 6 * ti, L = ti * G + c; if (L >= 192 * 4) return false;
        pg8::tile_order(L, 192, 4, u.pm, u.pn); u.seg = seg;
        const size_t am = (size_t)u.pm * pg8::TSTEP, bn = (size_t)u.pn * pg8::TSTEP;
        if (seg == 0) { u.A = PA + am; u.B = WPOT + bn; u.nt = 16; }
        else if (seg == 2) { u.A = FO + am; u.B = WFAT + bn; u.nt = 8; }
        else if (seg == 4) { u.A = FO + am + 1024; u.B = WFAT + bn + 1024; u.nt = 8; }
        else { u.A = XN + am; u.B = WGT + (size_t)(4 * (seg >> 1) + u.pn) * pg8::TSTEP; u.nt = 16; }
        return true;
    }
};
struct EpiP3 {
    static constexpr bool PERM = true;
    __device__ __forceinline__ void init(f32x4 (&acc)[2][2][4][2], const Unit&, int, int, int, int) const {
#pragma unroll
        for (int a = 0; a < 2; ++a)
#pragma unroll
            for (int b = 0; b < 2; ++b)
#pragma unroll
                for (int m = 0; m < 4; ++m)
#pragma unroll
                    for (int n = 0; n < 2; ++n) acc[a][b][m][n] = (f32x4){0.f, 0.f, 0.f, 0.f};
    }
    unsigned char* stash; const float* bgate; bf16_t* MERGED;
    __device__ __forceinline__ void operator()(const f32x4 (&acc)[2][2][4][2], const Unit& u, int wr, int wc, int fr, int fq) const {
        const int tid = threadIdx.x, seg = u.seg;
        const unsigned toff = (unsigned)tid * 16u; const __amdgpu_buffer_rsrc_t srs = __builtin_amdgcn_make_buffer_rsrc((void*)stash, (short)0, 262144, 0x00020000);
        if ((seg & 1) == 0) {
#pragma unroll
            for (int ai = 0; ai < 2; ++ai)
#pragma unroll
                for (int bj = 0; bj < 2; ++bj)
#pragma unroll
                    for (int m = 0; m < 4; ++m) { const f32x4 v0 = acc[ai][bj][m][0], v1 = acc[ai][bj][m][1];
                        u32x4 w; w.x = cvt_pk_bf16(v0[0], v0[1]); w.y = cvt_pk_bf16(v0[2], v0[3]); w.z = cvt_pk_bf16(v1[0], v1[1]); w.w = cvt_pk_bf16(v1[2], v1[3]);
                        __builtin_amdgcn_raw_buffer_store_b128(w, srs, toff, ((ai * 2 + bj) * 4 + m) * 8192, 0); }
        } else {
            const int bcol0 = (seg >> 1) * 1024 + u.pn * 256 + wc * 32 + 8 * fq;
            const int row0 = u.pm * 256 + wr * 64 + fr, col0 = u.pn * 256 + wc * 32 + 8 * fq;
#pragma unroll
            for (int bj = 0; bj < 2; ++bj) {
                const f32x4 b0 = *(const f32x4*)(bgate + bcol0 + bj * 128), b1 = *(const f32x4*)(bgate + bcol0 + bj * 128 + 4);
#pragma unroll
                for (int ai = 0; ai < 2; ++ai)
#pragma unroll
                    for (int m = 0; m < 4; ++m) { const int j = (ai * 2 + bj) * 4 + m;
                        const u32x4 yv = __builtin_amdgcn_raw_buffer_load_b128(srs, toff, j * 8192, 0);
                        const f32x4 a0 = acc[ai][bj][m][0] + b0, a1 = acc[ai][bj][m][1] + b1;
                        float r[8];
                        r[0] = sigmoid_f(a0[0]) * bflo(yv.x); r[1] = sigmoid_f(a0[1]) * bfhi(yv.x); r[2] = sigmoid_f(a0[2]) * bflo(yv.y); r[3] = sigmoid_f(a0[3]) * bfhi(yv.y);
                        r[4] = sigmoid_f(a1[0]) * bflo(yv.z); r[5] = sigmoid_f(a1[1]) * bfhi(yv.z); r[6] = sigmoid_f(a1[2]) * bflo(yv.w); r[7] = sigmoid_f(a1[3]) * bfhi(yv.w);
                        if (seg >= 3) { const u32x4 mv = __builtin_amdgcn_raw_buffer_load_b128(srs, toff, 131072 + j * 8192, 0);
                            r[0] += bflo(mv.x); r[1] += bfhi(mv.x); r[2] += bflo(mv.y); r[3] += bfhi(mv.y); r[4] += bflo(mv.z); r[5] += bfhi(mv.z); r[6] += bflo(mv.w); r[7] += bfhi(mv.w); }
                        u32x4 w; w.x = cvt_pk_bf16(r[0], r[1]); w.y = cvt_pk_bf16(r[2], r[3]); w.z = cvt_pk_bf16(r[4], r[5]); w.w = cvt_pk_bf16(r[6], r[7]);
                        if (seg < 5) __builtin_amdgcn_raw_buffer_store_b128(w, srs, toff, 131072 + j * 8192, 0);
                        else *(u32x4*)(MERGED + (size_t)(row0 + ai * 128 + m * 16) * 1024 + col0 + bj * 128) = w;
                        if (m == 3) asm volatile("" ::: "memory"); }
            }
        }
    }
};
struct SchedP4 {
    int G, c; const char *MERGED, *WOT;
    __device__ __forceinline__ bool next(int i, Unit& u) const {
        const int L = i * G + c; if (L >= 192 * 4) return false;
        pg8::tile_order(L, 192, 4, u.pm, u.pn); u.A = MERGED + (size_t)u.pm * pg8::TSTEP; u.B = WOT + (size_t)u.pn * pg8::TSTEP; u.nt = 16; u.seg = 0; return true;
    }
};
typedef int i32x4 __attribute__((ext_vector_type(4)));
__device__ __forceinline__ f32x4 ror8(f32x4 v) {
    const i32x4 s = __builtin_bit_cast(i32x4, v); i32x4 r;
    r[0] = __builtin_amdgcn_mov_dpp(s[0], 0x128, 0xf, 0xf, false);
    r[1] = __builtin_amdgcn_mov_dpp(s[1], 0x128, 0xf, 0xf, false);
    r[2] = __builtin_amdgcn_mov_dpp(s[2], 0x128, 0xf, 0xf, false);
    r[3] = __builtin_amdgcn_mov_dpp(s[3], 0x128, 0xf, 0xf, false);
    return __builtin_bit_cast(f32x4, r);
}
struct EpiP4 {
    static constexpr bool PERM = false;
    __device__ __forceinline__ void init(f32x4 (&acc)[2][2][4][2], const Unit&, int, int, int, int) const {
#pragma unroll
        for (int a = 0; a < 2; ++a)
#pragma unroll
            for (int b = 0; b < 2; ++b)
#pragma unroll
                for (int m = 0; m < 4; ++m)
#pragma unroll
                    for (int n = 0; n < 2; ++n) acc[a][b][m][n] = (f32x4){0.f, 0.f, 0.f, 0.f};
    }
    const float *xp, *xs; float* out;
    __device__ __forceinline__ void operator()(const f32x4 (&acc)[2][2][4][2], const Unit& u, int wr, int wc, int fr, int fq) const {
        const int row0 = u.pm * 256 + wr * 64 + fr, col0 = u.pn * 256 + wc * 32 + 4 * fq;
        const float* xb = (u.pm < MP / 256) ? xp : xs - (size_t)MP * DM;
#pragma unroll
        for (int ai = 0; ai < 2; ++ai)
#pragma unroll
            for (int m = 0; m < 4; ++m) { const size_t off = (size_t)(row0 + ai * 128 + m * 16) * DM + col0;
#pragma unroll
                for (int bj = 0; bj < 2; ++bj) { const f32x4 v0 = *(const f32x4*)(xb + off + bj * 128) + acc[ai][bj][m][0], v1 = *(const f32x4*)(xb + off + bj * 128 + 16) + acc[ai][bj][m][1];
                    const f32x4 t0 = ror8(v0), t1 = ror8(v1); const bool lo = fr < 8;
                    const size_t o2 = (size_t)(u.pm * 256 + wr * 64 + ai * 128 + m * 16 + (fr & 7)) * DM + col0 + (lo ? 0 : 16) + bj * 128;
                    *(f32x4*)(out + o2) = lo ? v0 : t1; *(f32x4*)(out + o2 + 8 * DM) = lo ? t0 : v1; }
                asm volatile("" ::: "memory"); }
    }
};

__device__ __forceinline__ void transpose_item(const float* W, int ldw, bf16_t* WT, int nblk, LAS float* scr, int item, int lane) {
    const int kb = item / nblk, nb = item % nblk, k0 = 64 * kb, n0 = 32 * nb;
    float tv[32];
#pragma unroll
    for (int i = 0; i < 32; ++i) tv[i] = W[(size_t)(k0 + 2 * i + (lane >> 5)) * ldw + n0 + (lane & 31)];
#pragma unroll
    for (int i = 0; i < 32; ++i) scr[(2 * i + (lane >> 5)) * 33 + (lane & 31)] = tv[i];
    LDS_WAIT(); asm volatile("" ::: "memory");
    const int c = lane & 7;
#pragma unroll
    for (int j = 0; j < 4; ++j) { const int n = (lane >> 3) + 8 * j; const LAS float* s = scr + (8 * c) * 33 + n;
        u32x4 o; o.x = pk2(s[0 * 33], s[1 * 33]); o.y = pk2(s[2 * 33], s[3 * 33]); o.z = pk2(s[4 * 33], s[5 * 33]); o.w = pk2(s[6 * 33], s[7 * 33]);
        *(u32x4*)(WT + (size_t)(n0 + n) * 1024 + k0 + 8 * c) = o; }
    LDS_WAIT(); asm volatile("" ::: "memory");
}
__device__ __forceinline__ void rms_row_to_bf16(const float* xrow, const float* gain, bf16_t* orow, int lane) {
    const f32x4* xr = (const f32x4*)xrow + lane; const f32x4* gr = (const f32x4*)gain + lane;
    f32x4 v[4]; float s = 0.f;
#pragma unroll
    for (int j = 0; j < 4; ++j) { v[j] = xr[64 * j]; s += (v[j].x * v[j].x + v[j].y * v[j].y) + (v[j].z * v[j].z + v[j].w * v[j].w); }
    const float r = 1.0f / sqrtf(wave_sum(s) * (1.f / DM) + EPS);
    u32x2* o8 = (u32x2*)orow + lane;
#pragma unroll
    for (int j = 0; j < 4; ++j) { const f32x4 g = gr[64 * j]; u32x2 w; w.x = pk2(v[j].x * r * g.x, v[j].y * r * g.y); w.y = pk2(v[j].z * r * g.z, v[j].w * r * g.w); o8[64 * j] = w; }
}
__device__ __forceinline__ void fold_item(const Ctx& F, int item) {
    constexpr int AP = 132;
    LAS float* As = (LAS float*)F.lds;
    LAS float* Bs = (LAS float*)(F.lds + 36864);
    LAS float* Ts = (LAS float*)(F.lds + 53248);
    LAS float* Wl = (LAS float*)(F.lds + 86016);
    const LAS f32x2* tab = (const LAS f32x2*)(F.lds + TAB_OFF);
    const int tid = F.tid, tk = tid & 63, tj = tid >> 6;
    float acc0[8], acc1[8];
#pragma unroll
    for (int j = 0; j < 8; ++j) { acc0[j] = 0.f; acc1[j] = 0.f; }
    const bool pool = item < 128;
    int g, k0, j0, sn = 0;
    if (pool) { g = item >> 5; k0 = ((item >> 2) & 7) * 128; j0 = (item & 3) * 64; }
    else { const int it = item - 128; g = it >> 5; sn = (it >> 4) & 1; k0 = ((it >> 1) & 7) * 128; j0 = (it & 1) * 64; }
    const int KC = pool ? 256 : 128;
    const float* Ab = F.w_in + (size_t)k0 * INW + (pool ? g * 256 : 2048 + g * 128);
    const float* Bb = F.w_pool_grp + (size_t)(g * 256) * 256 + j0;
    f32x4 ra[4], rb[2];
    const int lr = tid >> 4, lc = 4 * (tid & 15);
    auto gload = [&](int c0) {
#pragma unroll
        for (int i = 0; i < 4; ++i) ra[i] = *(const f32x4*)(Ab + (size_t)(lr + 32 * i) * INW + c0 + lc);
#pragma unroll
        for (int i = 0; i < 2; ++i) rb[i] = *(const f32x4*)(Bb + (size_t)(c0 + lr + 32 * i) * 256 + lc); };
    gload(0);
    __syncthreads();
    if (!pool) {
#pragma unroll
        for (int i = 0; i < 4; ++i) { const int idx = tid + 512 * i; *(LAS f32x4*)(Wl + 4 * idx) = *(const f32x4*)(F.w_four_grp + (size_t)(g * 128 + (idx >> 4)) * 128 + j0 + 4 * (idx & 15)); }
        __syncthreads();
        const int c = tid & 127, jq = tid >> 7; float t[16];
#pragma unroll
        for (int j = 0; j < 16; ++j) t[j] = 0.f;
#pragma unroll 4
        for (int d = 0; d < 128; ++d) { const f32x2 cs = tab[(c * d) & 127]; const float w = sn ? cs.y : cs.x;
            const LAS f32x4* wp = (const LAS f32x4*)(Wl + d * 64 + jq * 16);
#pragma unroll
            for (int q = 0; q < 4; ++q) { const f32x4 x = wp[q]; t[4 * q] += w * x.x; t[4 * q + 1] += w * x.y; t[4 * q + 2] += w * x.z; t[4 * q + 3] += w * x.w; } }
#pragma unroll
        for (int j = 0; j < 16; ++j) Ts[c * 64 + jq * 16 + j] = t[j] * 0.08838834764831845f;
    }
    for (int c0 = 0; c0 < KC; c0 += 64) {
        __syncthreads();
#pragma unroll
        for (int i = 0; i < 4; ++i) { const int k = lr + 32 * i; As[(lc + 0) * AP + k] = ra[i].x; As[(lc + 1) * AP + k] = ra[i].y; As[(lc + 2) * AP + k] = ra[i].z; As[(lc + 3) * AP + k] = ra[i].w; }
#pragma unroll
        for (int i = 0; i < 2; ++i) *(LAS f32x4*)(Bs + (lr + 32 * i) * 64 + lc) = rb[i];
        __syncthreads();
        if (c0 + 64 < KC) gload(c0 + 64);
        const LAS float* Bm = pool ? Bs : Ts + c0 * 64;
#pragma unroll 8
        for (int cc = 0; cc < 64; ++cc) { const f32x2 a = *(const LAS f32x2*)(As + cc * AP + 2 * tk);
            const f32x4 b0 = *(const LAS f32x4*)(Bm + cc * 64 + tj * 8), b1 = *(const LAS f32x4*)(Bm + cc * 64 + tj * 8 + 4);
            acc0[0] += a.x * b0.x; acc0[1] += a.x * b0.y; acc0[2] += a.x * b0.z; acc0[3] += a.x * b0.w; acc0[4] += a.x * b1.x; acc0[5] += a.x * b1.y; acc0[6] += a.x * b1.z; acc0[7] += a.x * b1.w;
            acc1[0] += a.y * b0.x; acc1[1] += a.y * b0.y; acc1[2] += a.y * b0.z; acc1[3] += a.y * b0.w; acc1[4] += a.y * b1.x; acc1[5] += a.y * b1.y; acc1[6] += a.y * b1.z; acc1[7] += a.y * b1.w; }
    }
#pragma unroll
    for (int j = 0; j < 8; ++j) { const int n = (pool ? g * 256 : 2048 + sn * 512 + g * 128) + j0 + tj * 8 + j; const float psc = F.pool_scale[n & 1023]; const float sc = pool ? psc : 1.0f;
        *(unsigned*)(F.W1T + (size_t)n * 1024 + k0 + 2 * tk) = pk2(acc0[j] * sc, acc1[j] * sc); }
    __syncthreads();
}
__device__ __forceinline__ void build_tables(const Ctx& F, bf16_t* T);
__device__ __forceinline__ void p0_prologue(const Ctx& F) {
    build_tables(F, F.TAB);
    for (int it = F.bid; it < 256; it += F.G) fold_item(F, it);
    __syncthreads();
    LAS float* scr = (LAS float*)(F.lds + F.wave * 16384);
    const int gw = F.bid * NWAVES + F.wave, NGW = F.G * NWAVES;
    constexpr int I0 = 16 * 32, I1 = 16 * 16, I4 = 16 * 96, I5 = 16 * 32, I6 = 8 * 32;
    constexpr int NITEMS = I0 + 3 * I1 + I4 + I5 + 2 * I6 + 2 * I5;
    for (int it = gw; it < NITEMS; it += NGW) {
        int r = it;
        if (r < I0) { transpose_item(F.w_in + 1024, INW, F.W1T + (size_t)1024 * 1024, 32, scr, r, F.lane); continue; } r -= I0;
        if (r < I1) { transpose_item(F.w_in + 2560, INW, F.W1T + (size_t)3072 * 1024, 16, scr, r, F.lane); continue; } r -= I1;
        if (r < I1) { transpose_item(F.w_in + 3072, INW, F.W1T + (size_t)3584 * 1024, 16, scr, r, F.lane); continue; } r -= I1;
        if (r < I1) { transpose_item(F.w_in + 3584, INW, F.W1T + (size_t)4096 * 1024, 16, scr, r, F.lane); continue; } r -= I1;
        if (r < I4) { transpose_item(F.w_in + 4096, INW, F.WGT, 96, scr, r, F.lane); continue; } r -= I4;
        if (r < I5) { transpose_item(F.w_pool_out, 1024, F.WPOT, 32, scr, r, F.lane); continue; } r -= I5;
        if (r < I6) { transpose_item(F.w_four_out, 1024, F.WFAT, 32, scr, r, F.lane); continue; } r -= I6;
        if (r < I6) { transpose_item(F.w_attn_out, 1024, F.WFAT + 512, 32, scr, r, F.lane); continue; } r -= I6;
        if (r < I5) { transpose_item(F.w_o, 1024, F.WOT, 32, scr, r, F.lane); continue; } r -= I5;
        transpose_item(F.w_kv, 1024, F.WKVT, 32, scr, r, F.lane);
    }
    {
        constexpr int TOT = MT + MMEM;
        auto src_of = [&](int m) -> const float* { return m < MP ? F.xp + (size_t)m * DM : m < MT ? F.xs + (size_t)(m - MP) * DM : (m - MT) < 16 * NMEM ? F.memp + (size_t)(m - MT) * DM : F.mems + (size_t)(m - MT - 16 * NMEM) * DM; };
        int m = gw; f32x4 v[4];
        if (m < TOT) { const f32x4* xr = (const f32x4*)src_of(m) + F.lane;
#pragma unroll
            for (int j = 0; j < 4; ++j) v[j] = xr[64 * j]; }
        while (m < TOT) {
            const int mn = m + NGW; f32x4 nx[4];
            if (mn < TOT) { const f32x4* xr = (const f32x4*)src_of(mn) + F.lane;
#pragma unroll
                for (int j = 0; j < 4; ++j) nx[j] = xr[64 * j]; }
            float sq = 0.f;
#pragma unroll
            for (int j = 0; j < 4; ++j) sq += (v[j].x * v[j].x + v[j].y * v[j].y) + (v[j].z * v[j].z + v[j].w * v[j].w);
            const float r = 1.0f / sqrtf(wave_sum(sq) * (1.f / DM) + EPS);
            const f32x4* gr = (const f32x4*)(m < MT ? F.norm_in : F.norm_mem) + F.lane;
            u32x2* o8 = (u32x2*)(m < MT ? F.XN + (size_t)m * DM : F.MN + (size_t)(m - MT) * DM) + F.lane;
#pragma unroll
            for (int j = 0; j < 4; ++j) { const f32x4 g = gr[64 * j]; u32x2 w; w.x = pk2(v[j].x * r * g.x, v[j].y * r * g.y); w.y = pk2(v[j].z * r * g.z, v[j].w * r * g.w); o8[64 * j] = w; }
#pragma unroll
            for (int j = 0; j < 4; ++j) v[j] = nx[j];
            m = mn;
        }
    }
}

__device__ __forceinline__ void seq_of_row(int row, int& r0, int& S) { if (row < MP) { r0 = row & ~2047; S = 2048; } else { r0 = MP; S = MS; } }
__device__ __forceinline__ void acc4(f32x4& s, u32x2 v, float sg) { s.x += sg * bflo(v.x); s.y += sg * bfhi(v.x); s.z += sg * bflo(v.y); s.w += sg * bfhi(v.y); }
template <int H>
__device__ __forceinline__ void pool_walk(const bf16_t* xb, bf16_t* gb, int t0, int S) {
    constexpr int R = 2 * H;
    u32x2 ring[R]; f32x4 s = (f32x4){0.f, 0.f, 0.f, 0.f};
#pragma unroll
    for (int i = 0; i < R; ++i) { const int r = t0 - H + i; u32x2 v; v.x = 0u; v.y = 0u; if (r >= 0 && r < S) v = *(const u32x2*)(xb + (size_t)r * 1024); ring[i] = v; acc4(s, v, 1.f); }
#pragma unroll
    for (int j = 0; j < 32; ++j) {
        const int t = t0 + j, lo = t - H < 0 ? 0 : t - H, hi = t + H > S ? S : t + H;
        const float inv = 1.0f / (float)(hi - lo);
        const u32x2 me = ring[(j + H) % R], gt = *(const u32x2*)(gb + (size_t)t * 1024);
        u32x2 o;
        o.x = pk2((s.x * inv - bflo(me.x)) * bflo(gt.x), (s.y * inv - bfhi(me.x)) * bfhi(gt.x));
        o.y = pk2((s.z * inv - bflo(me.y)) * bflo(gt.y), (s.w * inv - bfhi(me.y)) * bfhi(gt.y));
        *(u32x2*)(gb + (size_t)t * 1024) = o;
        if (j < 31) { u32x2 nv; nv.x = 0u; nv.y = 0u; if (t + H < S) nv = *(const u32x2*)(xb + (size_t)(t + H) * 1024);
            acc4(s, ring[j % R], -1.f); acc4(s, nv, 1.f); ring[j % R] = nv; }
    }
}
__device__ __forceinline__ void pool_phase(const Ctx& F) {
    const int gw = F.bid * NWAVES + F.wave, NGW = F.G * NWAVES;
    for (int it = gw; it < (MT / 32) * 4; it += NGW) {
        const int tile = it >> 2, g = it & 3, row0 = tile * 32; int r0, S; seq_of_row(row0, r0, S);
        const int col = g * 256 + F.lane * 4;
        const bf16_t* xb = F.PVF + (size_t)r0 * 1024 + col; bf16_t* gb = F.PA + (size_t)r0 * 1024 + col;
        if (g == 0) pool_walk<1>(xb, gb, row0 - r0, S); else if (g == 1) pool_walk<2>(xb, gb, row0 - r0, S); else if (g == 2) pool_walk<4>(xb, gb, row0 - r0, S); else pool_walk<8>(xb, gb, row0 - r0, S);
    }
}
__device__ __forceinline__ void dft1_phase(const Ctx& F) {
    const LAS f32x2* tab = (const LAS f32x2*)(F.lds + TAB_OFF);
    for (int it = F.bid; it < 16384 + 8192; it += F.G) {
        int seq, s2, head, chk, N1, r0, S, sh;
        if (it < 16384) { seq = it >> 10; const int r = it & 1023; s2 = r >> 3; head = (r >> 1) & 3; chk = r & 1; N1 = 16; r0 = seq * 2048; S = 2048; sh = 3; }
        else { const int r = it - 16384; seq = 16; s2 = r >> 6; head = (r >> 4) & 3; chk = r & 15; N1 = 128; r0 = MP; S = MS; sh = 0; }
        const int k1 = chk * 8 + (F.tid >> 6), col = head * 128 + 2 * (F.tid & 63);
        float yr0 = 0.f, yr1 = 0.f, yi0 = 0.f, yi1 = 0.f;
        for (int s1 = 0; s1 < N1; ++s1) {
            const size_t ro = (size_t)(r0 + 128 * s1 + s2) * 1024 + col;
            const unsigned av = *(const unsigned*)(F.AB + ro), bv = *(const unsigned*)(F.AB + ro + 512);
            const f32x2 cs = tab[((k1 * s1) << sh) & 127];
            const float a0 = bflo(av), a1 = bfhi(av), b0 = bflo(bv), b1 = bfhi(bv);
            yr0 += cs.x * a0 - cs.y * b0; yi0 += cs.y * a0 + cs.x * b0;
            yr1 += cs.x * a1 - cs.y * b1; yi1 += cs.y * a1 + cs.x * b1;
        }
        float tc, ts; { const float ang = 2.0f * (float)(k1 * s2) / (float)S; ts = sinpif(ang); tc = cospif(ang); }
        const float sc = N1 == 16 ? 0.25f : 0.08838834764831845f; tc *= sc; ts *= sc;
        const size_t wo = (size_t)(r0 + 128 * k1 + s2) * 1024 + col;
        *(unsigned*)(F.Y1 + wo) = pk2(yr0 * tc - yi0 * ts, yr1 * tc - yi1 * ts);
        *(unsigned*)(F.Y1 + wo + 512) = pk2(yr0 * ts + yi0 * tc, yr1 * ts + yi1 * tc);
    }
}
__device__ __forceinline__ void dft2_phase(const Ctx& F) {
    const LAS f32x2* tab = (const LAS f32x2*)(F.lds + TAB_OFF);
    for (int it = F.bid; it < 16384 + 8192; it += F.G) {
        int seq, k1, head, chk, N1, r0;
        if (it < 16384) { seq = it >> 10; const int r = it & 1023; k1 = r >> 6; head = (r >> 4) & 3; chk = r & 15; N1 = 16; r0 = seq * 2048; }
        else { const int r = it - 16384; seq = 16; k1 = r >> 6; head = (r >> 4) & 3; chk = r & 15; N1 = 128; r0 = MP; }
        const int k2 = chk * 8 + (F.tid >> 6), col = head * 128 + 2 * (F.tid & 63);
        float f0 = 0.f, f1 = 0.f;
        for (int s2 = 0; s2 < 128; ++s2) {
            const size_t ro = (size_t)(r0 + 128 * k1 + s2) * 1024 + col;
            const unsigned rv = *(const unsigned*)(F.Y1 + ro), iv = *(const unsigned*)(F.Y1 + ro + 512);
            const f32x2 cs = tab[(k2 * s2) & 127];
            f0 += cs.x * bflo(rv) - cs.y * bflo(iv); f1 += cs.x * bfhi(rv) - cs.y * bfhi(iv);
        }
        const size_t wo = (size_t)(r0 + k1 + N1 * k2) * 1024 + col;
        const unsigned gt = *(const unsigned*)(F.FO + wo);
        *(unsigned*)(F.FO + wo) = pk2(f0 * 0.08838834764831845f * bflo(gt), f1 * 0.08838834764831845f * bfhi(gt));
    }
}

namespace dft {
using s16x4 = __attribute__((ext_vector_type(4))) short;
constexpr int ROWB = 288;
template <int OFF> __device__ __forceinline__ s16x4 tr(unsigned a) { s16x4 r; asm volatile("ds_read_b64_tr_b16 %0, %1 offset:%2" : "=&v"(r) : "v"(a), "i"(OFF) : "memory"); return r; }
__device__ __forceinline__ bf16x8 efrag(const bf16_t* E, int ldE, int row, int ks, int G) {
    const bf16_t* p = E + (size_t)row * ldE + 32 * ks + 16 * (G >> 1) + 4 * (G & 1);
    const u32x2 a = *(const u32x2*)p, b = *(const u32x2*)(p + 8);
    u32x4 w; w.x = a.x; w.y = a.y; w.z = b.x; w.w = b.y; return __builtin_bit_cast(bf16x8, w);
}
template <int MT, int KS>
__device__ __forceinline__ void mma(f32x4 (&acc)[MT][8], const bf16x8 (&ef)[MT][KS], unsigned vbase) {
#pragma unroll
    for (int ks = 0; ks < KS; ++ks) {
        const unsigned b = vbase + ks * (32 * ROWB);
        s16x4 lo[8], hi[8];
        lo[0] = tr<0>(b);   hi[0] = tr<8 * ROWB + 0>(b);   lo[1] = tr<32>(b);  hi[1] = tr<8 * ROWB + 32>(b);  lo[2] = tr<64>(b);  hi[2] = tr<8 * ROWB + 64>(b);  lo[3] = tr<96>(b);  hi[3] = tr<8 * ROWB + 96>(b);
        lo[4] = tr<128>(b); hi[4] = tr<8 * ROWB + 128>(b); lo[5] = tr<160>(b); hi[5] = tr<8 * ROWB + 160>(b); lo[6] = tr<192>(b); hi[6] = tr<8 * ROWB + 192>(b); lo[7] = tr<224>(b); hi[7] = tr<8 * ROWB + 224>(b);
        asm volatile("s_waitcnt lgkmcnt(0)" ::: "memory"); __builtin_amdgcn_sched_barrier(0);
#pragma unroll
        for (int nt = 0; nt < 8; ++nt) { const bf16x8 vf = (bf16x8){lo[nt][0], lo[nt][1], lo[nt][2], lo[nt][3], hi[nt][0], hi[nt][1], hi[nt][2], hi[nt][3]};
#pragma unroll
            for (int mt = 0; mt < MT; ++mt) acc[mt][nt] = __builtin_amdgcn_mfma_f32_16x16x32_bf16(vf, ef[mt][ks], acc[mt][nt], 0, 0, 0); }
    }
}
struct Stage { u32x4 v[8]; };
template <int MODE> __device__ __forceinline__ void load(Stage& st, const bf16_t* buf, int r0, int x, int h, int tid) {
#pragma unroll
    for (int i = 0; i < 8; ++i) { const int c = tid + 512 * i, kr = c >> 4, c16 = c & 15; int row, part;
        if (MODE == 0) { row = r0 + 128 * x + (kr & 127); part = kr >> 7; }
        else if (MODE == 1) { const int kk = kr & 31; row = r0 + 128 * (kk & 15) + x + (kr >> 5); part = kk >> 4; }
        else { row = r0 + 128 * x + (kr & 127); part = kr >> 7; }
        st.v[i] = *(const u32x4*)(buf + (size_t)row * 1024 + part * 512 + h * 128 + c16 * 8); }
}
__device__ __forceinline__ void store_image(const Stage& st, LAS unsigned char* img, int tid) {
#pragma unroll
    for (int i = 0; i < 8; ++i) { const int c = tid + 512 * i; *(LAS u32x4*)(img + (c >> 4) * ROWB + (c & 15) * 16) = st.v[i]; }
}
}
template <int N1>
__device__ __forceinline__ void dft1_mfma(const Ctx& F, const bf16_t* E, bf16_t* dst) {
    constexpr int KS = N1 == 128 ? 8 : 1, MODE = N1 == 128 ? 0 : 1, LDE = 2 * N1;
    const int lane = F.lane, G = lane >> 4, i16 = lane & 15, w = F.wave;
    const int nitems = N1 == 128 ? 128 * 4 : 16 * 16 * 4;
    LAS unsigned char* img = F.lds;
    const unsigned vbase = (unsigned)(uintptr_t)img + (16 * (G >> 1) + 4 * (G & 1) + (i16 >> 2)) * dft::ROWB + 8 * (lane & 3) + (N1 == 128 ? 0 : w * 32 * dft::ROWB);
    const int k1 = (N1 == 128 ? 16 * w : 0) + i16;
    bf16x8 ef[2][KS];
#pragma unroll
    for (int ks = 0; ks < KS; ++ks) { ef[0][ks] = dft::efrag(E, LDE, k1, ks, G); ef[1][ks] = dft::efrag(E, LDE, N1 + k1, ks, G); }
    dft::Stage st;
    int it = F.bid;
    auto decode = [&](int item, int& r0, int& x, int& h) { if (N1 == 128) { r0 = MP; x = (item & 255) >> 1; h = 2 * (item & 1) + (item >> 8); }     else { r0 = (item >> 6) * 2048; x = ((item >> 2) & 15) * 8; h = item & 3; } };
    int r0, x, h;
    if (it < nitems) { decode(it, r0, x, h); dft::load<MODE>(st, F.AB, r0, x, h, F.tid); }
    for (; it < nitems; it += F.G) {
        decode(it, r0, x, h);
        __syncthreads();
        dft::store_image(st, img, F.tid);
        __syncthreads();
        { const int nx = it + F.G; if (nx < nitems) { int r0n, xn, hn; decode(nx, r0n, xn, hn); dft::load<MODE>(st, F.AB, r0n, xn, hn, F.tid); } }
        f32x4 acc[2][8];
#pragma unroll
        for (int a = 0; a < 2; ++a)
#pragma unroll
            for (int n = 0; n < 8; ++n) acc[a][n] = (f32x4){0.f, 0.f, 0.f, 0.f};
        dft::mma<2, KS>(acc, ef, vbase);
        const int s2 = N1 == 128 ? x : x + w, S = N1 == 128 ? MS : 2048;
        const float ang = 2.0f * (float)(k1 * s2) / (float)S; const float ts = sinpif(ang), tc = cospif(ang);
        bf16_t* orow = dst + (size_t)(r0 + 128 * k1 + s2) * 1024 + h * 128 + 4 * G;
#pragma unroll
        for (int nt = 0; nt < 8; ++nt) { const f32x4 yr = acc[0][nt], yi = acc[1][nt];
            u32x2 re, im;
            re.x = cvt_pk_bf16(yr[0] * tc - yi[0] * ts, yr[1] * tc - yi[1] * ts); re.y = cvt_pk_bf16(yr[2] * tc - yi[2] * ts, yr[3] * tc - yi[3] * ts);
            im.x = cvt_pk_bf16(yr[0] * ts + yi[0] * tc, yr[1] * ts + yi[1] * tc); im.y = cvt_pk_bf16(yr[2] * ts + yi[2] * tc, yr[3] * ts + yi[3] * tc);
            *(u32x2*)(orow + 16 * nt) = re; *(u32x2*)(orow + 512 + 16 * nt) = im; }
    }
    __syncthreads();
}
__device__ __forceinline__ void dft2_mfma(const Ctx& F, const bf16_t* E) {
    const int lane = F.lane, G = lane >> 4, i16 = lane & 15, w = F.wave;
    constexpr int nitems = 16 * 16 * 4 + 128 * 4;
    LAS unsigned char* img = F.lds;
    const unsigned vbase = (unsigned)(uintptr_t)img + (16 * (G >> 1) + 4 * (G & 1) + (i16 >> 2)) * dft::ROWB + 8 * (lane & 3);
    const int k2 = 16 * w + i16;
    bf16x8 ef[1][8];
#pragma unroll
    for (int ks = 0; ks < 8; ++ks) ef[0][ks] = dft::efrag(E, 256, k2, ks, G);
    dft::Stage st;
    int it = F.bid;
    auto decode = [&](int item, int& r0, int& x, int& h, int& N1) { if (item < 1024) { r0 = (item >> 6) * 2048; x = (item >> 2) & 15; h = item & 3; N1 = 16; } else { const int j = item - 1024; r0 = MP; x = j >> 2; h = j & 3; N1 = 128; } };
    int r0, x, h, N1;
    if (it < nitems) { decode(it, r0, x, h, N1); dft::load<2>(st, N1 == 128 ? F.Y1 : F.AB, r0, x, h, F.tid); }
    for (; it < nitems; it += F.G) {
        decode(it, r0, x, h, N1);
        __syncthreads();
        dft::store_image(st, img, F.tid);
        __syncthreads();
        { const int nx = it + F.G; if (nx < nitems) { int r0n, xn, hn, nn; decode(nx, r0n, xn, hn, nn); dft::load<2>(st, nn == 128 ? F.Y1 : F.AB, r0n, xn, hn, F.tid); } }
        f32x4 acc[1][8];
#pragma unroll
        for (int n = 0; n < 8; ++n) acc[0][n] = (f32x4){0.f, 0.f, 0.f, 0.f};
        dft::mma<1, 8>(acc, ef, vbase);
        bf16_t* orow = F.FO + (size_t)(r0 + x + N1 * k2) * 1024 + h * 128 + 4 * G;
#pragma unroll
        for (int nt = 0; nt < 8; ++nt) { const f32x4 f = acc[0][nt]; const u32x2 g = *(const u32x2*)(orow + 16 * nt);
            u32x2 o; o.x = cvt_pk_bf16(f[0] * bflo(g.x), f[1] * bfhi(g.x)); o.y = cvt_pk_bf16(f[2] * bflo(g.y), f[3] * bfhi(g.y));
            *(u32x2*)(orow + 16 * nt) = o; }
    }
    __syncthreads();
}
constexpr size_t WS_TAB = 42 * MiB; constexpr int TAB_E116 = 65536, TAB_E2 = 65536 + 1024, TAB_N = 65536 + 1024 + 32768;
__device__ __forceinline__ void build_tables(const Ctx& F, bf16_t* T) {
    for (int idx = F.bid * NTHR + F.tid; idx < TAB_N; idx += F.G * NTHR) {
        float v;
        if (idx < TAB_E116) { const int m = idx >> 8, k = idx & 255, ri = m >> 7, k1 = m & 127, rp = k >> 7, s1 = k & 127; const float a = (float)((k1 * s1) & 127) * (1.0f / 64.0f), c = cospif(a), sn = sinpif(a);
            v = (ri == rp ? c : (ri == 0 ? -sn : sn)) * 0.08838834764831845f; }
        else if (idx < TAB_E2) { const int j = idx - TAB_E116, m = j >> 5, k = j & 31, ri = m >> 4, k1 = m & 15, rp = k >> 4, s1 = k & 15; const float a = (float)((k1 * s1) & 15) * (1.0f / 8.0f), c = cospif(a), sn = sinpif(a);
            v = (ri == rp ? c : (ri == 0 ? -sn : sn)) * 0.25f; }
        else { const int j = idx - TAB_E2, m = j >> 8, k = j & 255, rp = k >> 7, s2 = k & 127; const float a = (float)((m * s2) & 127) * (1.0f / 64.0f);
            v = (rp == 0 ? cospif(a) : -sinpif(a)) * 0.08838834764831845f; }
        T[idx] = (bf16_t)f2bf(v);
    }
}
__device__ __forceinline__ void attn_phase_simple(const Ctx& F) {
    const int gw = F.bid * NWAVES + F.wave, NGW = F.G * NWAVES, lane = F.lane;
    for (int it = gw; it < MT * 4; it += NGW) {
        const int row = it >> 2, h = it & 3, seq = row < MP ? row >> 11 : 16;
        const bf16_t* q = F.Q + (size_t)row * 512 + h * 128;
        const bf16_t* Kb = F.KV + (size_t)(seq * NMEM) * 1024 + h * 128;
        const bf16_t* Vb = Kb + 512;
        float s[4] = {0.f, 0.f, 0.f, 0.f};
        for (int d = 0; d < 128; d += 8) {
            const u32x4 qv = *(const u32x4*)(q + d);
            const float q0 = bflo(qv.x), q1 = bfhi(qv.x), q2 = bflo(qv.y), q3 = bfhi(qv.y), q4 = bflo(qv.z), q5 = bfhi(qv.z), q6 = bflo(qv.w), q7 = bfhi(qv.w);
#pragma unroll
            for (int i = 0; i < 4; ++i) { const u32x4 kv = *(const u32x4*)(Kb + (size_t)(lane + 64 * i) * 1024 + d);
                s[i] += q0 * bflo(kv.x) + q1 * bfhi(kv.x) + q2 * bflo(kv.y) + q3 * bfhi(kv.y) + q4 * bflo(kv.z) + q5 * bfhi(kv.z) + q6 * bflo(kv.w) + q7 * bfhi(kv.w); }
        }
        const float scale = 0.08838834764831845f;
#pragma unroll
        for (int i = 0; i < 4; ++i) s[i] *= scale;
        const float mx = wave_max(fmaxf(fmaxf(s[0], s[1]), fmaxf(s[2], s[3])));
        float p[4], l = 0.f;
#pragma unroll
        for (int i = 0; i < 4; ++i) { p[i] = __expf(s[i] - mx); l += p[i]; }
        l = wave_sum(l);
        float o0 = 0.f, o1 = 0.f;
#pragma unroll
        for (int i = 0; i < 4; ++i)
            for (int kk = 0; kk < 64; ++kk) { const float pk = __shfl(p[i], kk); const unsigned vv = *(const unsigned*)(Vb + (size_t)(64 * i + kk) * 1024 + 2 * lane); o0 += pk * bflo(vv); o1 += pk * bfhi(vv); }
        const float rl = 1.0f / l;
        unsigned* dst = (unsigned*)(F.FO + (size_t)row * 1024 + 512 + h * 128 + 2 * lane);
        const unsigned gt = *dst;
        *dst = pk2(o0 * rl * bflo(gt), o1 * rl * bfhi(gt));
    }
}

namespace att {
using bf16 = unsigned short;
using s16x4  = __attribute__((ext_vector_type(4))) short;
using f32x16 = __attribute__((ext_vector_type(16))) float;
constexpr int D = 128, NW = 8, QBLK = 32, KVBLK = 64;
constexpr float SCALE = 0.088388347648318440f;
constexpr float THR = 8.f;
constexpr int SDEPTH = 2;
constexpr int LDQ = 512, LDK = 1024, LDO = 1024;
constexpr size_t SHM_V = KVBLK * D * 2, SHM_K = KVBLK * D * 2, SHM_ATTN = 2 * SHM_V + 2 * SHM_K + NW * 64 * 4;
#define KSWZ(row, colB) ((row) * 256 + ((colB) ^ (((row) & 7) << 4)))
#define SBAR() __builtin_amdgcn_sched_barrier(0)
__device__ __forceinline__ int crow(int r, int hi) { return (r & 3) + 8 * (r >> 2) + 4 * hi; }
__device__ __forceinline__ unsigned cvtpk(float lo, float hi) { unsigned r; asm volatile("v_cvt_pk_bf16_f32 %0, %1, %2" : "=v"(r) : "v"(lo), "v"(hi)); return r; }
__device__ __forceinline__ bf16x8 ld8(const bf16* p) { return *reinterpret_cast<const bf16x8*>(p); }
__device__ __forceinline__ void partialSM(f32x16& p0, f32x16& p1, float& m_reg, float& mn, float& alpha) {
  constexpr float C = SCALE * 1.4426950408889634f;
  float pmax = p0[0]; for (int r = 1; r < 16; ++r) pmax = fmaxf(pmax, p0[r]); for (int r = 0; r < 16; ++r) pmax = fmaxf(pmax, p1[r]);
  { auto rr = __builtin_amdgcn_permlane32_swap(__float_as_uint(pmax), __float_as_uint(pmax), false, false);
    pmax = fmaxf(__uint_as_float(rr[0]), __uint_as_float(rr[1])); }
  if (__builtin_expect(__all(pmax - m_reg <= THR / SCALE), 1)) { mn = m_reg; alpha = 1.f; }
  else { mn = fmaxf(m_reg, pmax); alpha = __builtin_amdgcn_exp2f((m_reg - mn) * C); m_reg = mn; }
  float mnC = -mn * C;
  for (int r = 0; r < 16; ++r) p0[r] = fmaf(p0[r], C, mnC); for (int r = 0; r < 16; ++r) p1[r] = fmaf(p1[r], C, mnC);
  for (int r = 0; r < 16; ++r) p0[r] = __builtin_amdgcn_exp2f(p0[r]);
}
__device__ __forceinline__ void finishSM(f32x16& p0, f32x16& p1, float alpha, float& l_reg, bf16x8& pa0, bf16x8& pa1, bf16x8& pa2, bf16x8& pa3) {
  for (int r = 0; r < 16; ++r) p1[r] = __builtin_amdgcn_exp2f(p1[r]);
  float ps = 0; for (int r = 0; r < 16; ++r) ps += p0[r]; for (int r = 0; r < 16; ++r) ps += p1[r];
  { auto rr = __builtin_amdgcn_permlane32_swap(__float_as_uint(ps), __float_as_uint(ps), false, false);
    ps = __uint_as_float(rr[0]) + __uint_as_float(rr[1]); }
  l_reg = l_reg * alpha + ps;
#define PK4(P, BASE, OUT) do { unsigned a0 = cvtpk(P[BASE + 0], P[BASE + 1]), a1 = cvtpk(P[BASE + 2], P[BASE + 3]);   \
    unsigned b0 = cvtpk(P[BASE + 4], P[BASE + 5]), b1 = cvtpk(P[BASE + 6], P[BASE + 7]);                              \
    auto r0 = __builtin_amdgcn_permlane32_swap(a0, b0, false, false); auto r1 = __builtin_amdgcn_permlane32_swap(a1, b1, false, false); \
    u32x4 w = {r0[0], r1[0], r0[1], r1[1]}; OUT = *reinterpret_cast<bf16x8*>(&w); } while (0)
  PK4(p0, 0, pa0); PK4(p0, 8, pa1); PK4(p1, 0, pa2); PK4(p1, 8, pa3);
#undef PK4
}
__device__ __forceinline__ void qkt(f32x16& p0, f32x16& p1, const bf16* Ks, const bf16x8* qr, int r32, int hi) {
  p0 = f32x16{}; p1 = f32x16{};
  for (int d0 = 0; d0 < 8; ++d0) { int cb = (d0 * 16 + hi * 8) * 2;
    bf16x8 b0 = *reinterpret_cast<const bf16x8*>((const char*)Ks + KSWZ(r32, cb));
    bf16x8 b1 = *reinterpret_cast<const bf16x8*>((const char*)Ks + KSWZ(32 + r32, cb));
    p0 = __builtin_amdgcn_mfma_f32_32x32x16_bf16(b0, qr[d0], p0, 0, 0, 0);
    p1 = __builtin_amdgcn_mfma_f32_32x32x16_bf16(b1, qr[d0], p1, 0, 0, 0); }
}
__device__ __forceinline__ int v_st(int k, int c) { const int kk = (k & ~0xC) | ((k & 4) << 1) | ((k & 8) >> 1); return ((kk >> 3) * 4 + (c >> 5)) * 512 + ((kk & 7) * 32 + (c & 31)) * 2; }
__device__ __forceinline__ int v_rd_base(int lane) { return ((lane & 3) << 3) | (((lane >> 2) & 3) << 6) | (((lane >> 4) & 1) << 5) | (((lane >> 5) & 1) << 8); }
constexpr int v_rd_off(int d0, int ks, int half) { return d0 * 512 + ks * 4096 + half * 2048; }
template <int OFF> __device__ __forceinline__ s16x4 tr_read(int vb) {
  s16x4 r; asm volatile("ds_read_b64_tr_b16 %0, %1 offset:%2" : "=&v"(r) : "v"(vb), "i"(OFF) : "memory"); return r;
}
template <int D0> __device__ __forceinline__ void pv_one(f32x16& od, int vb, bf16x8 pa0, bf16x8 pa1, bf16x8 pa2, bf16x8 pa3) {
  const s16x4 l0 = tr_read<v_rd_off(D0, 0, 0)>(vb), h0 = tr_read<v_rd_off(D0, 0, 1)>(vb), l1 = tr_read<v_rd_off(D0, 1, 0)>(vb), h1 = tr_read<v_rd_off(D0, 1, 1)>(vb);
  const s16x4 l2 = tr_read<v_rd_off(D0, 2, 0)>(vb), h2 = tr_read<v_rd_off(D0, 2, 1)>(vb), l3 = tr_read<v_rd_off(D0, 3, 0)>(vb), h3 = tr_read<v_rd_off(D0, 3, 1)>(vb);
  asm volatile("s_waitcnt lgkmcnt(0)" ::: "memory"); SBAR();
#define PK(L, H) (bf16x8){L[0], L[1], L[2], L[3], H[0], H[1], H[2], H[3]}
  od = __builtin_amdgcn_mfma_f32_32x32x16_bf16(pa0, PK(l0, h0), od, 0, 0, 0);
  od = __builtin_amdgcn_mfma_f32_32x32x16_bf16(pa1, PK(l1, h1), od, 0, 0, 0);
  od = __builtin_amdgcn_mfma_f32_32x32x16_bf16(pa2, PK(l2, h2), od, 0, 0, 0);
  od = __builtin_amdgcn_mfma_f32_32x32x16_bf16(pa3, PK(l3, h3), od, 0, 0, 0);
#undef PK
}
__device__ __forceinline__ void pv_d0(f32x16* o, int vb, bf16x8 pa0, bf16x8 pa1, bf16x8 pa2, bf16x8 pa3) {
  pv_one<0>(o[0], vb, pa0, pa1, pa2, pa3); pv_one<1>(o[1], vb, pa0, pa1, pa2, pa3); pv_one<2>(o[2], vb, pa0, pa1, pa2, pa3); pv_one<3>(o[3], vb, pa0, pa1, pa2, pa3);
}
__device__ __forceinline__ void attn_unit(const bf16* __restrict__ Qb, const bf16* __restrict__ Kh, const bf16* __restrict__ Vh, bf16* __restrict__ Ob, int seq, char* lds) {
  const int tid = threadIdx.x, wid = tid >> 6, lane = tid & 63, r32 = lane & 31, hi = lane >> 5;
  bf16* V_lds = (bf16*)lds; bf16* K_lds = (bf16*)(lds + 2 * SHM_V);
  float* ws = (float*)(lds + 2 * SHM_V + 2 * SHM_K) + wid * 64; float* li_l = ws; float* al_l = ws + 32;
  float m_reg = -1e30f, l_reg = 0; f32x16 o[4] = {}; bf16x8 qr[8];
  const bf16* Qw = Qb + (long)(wid * QBLK + r32) * LDQ + hi * 8;
#pragma unroll
  for (int d0 = 0; d0 < 8; ++d0) qr[d0] = ld8(Qw + d0 * 16);
  const int sr = tid >> 4, sc = (tid & 15) * 8, vst0 = v_st(sr, sc), vst1 = v_st(32 + sr, sc);
  const int vb0 = (int)(uintptr_t)V_lds + v_rd_base(lane);
  struct { bf16x8 vs0, vs1, ks0, ks1; } sr_[SDEPTH];
#define SLOAD(i, k0) do { sr_[i].vs0 = ld8(&Vh[(long)((k0) + sr) * LDK + sc]); sr_[i].vs1 = ld8(&Vh[(long)((k0) + 32 + sr) * LDK + sc]); \
    sr_[i].ks0 = ld8(&Kh[(long)((k0) + sr) * LDK + sc]); sr_[i].ks1 = ld8(&Kh[(long)((k0) + 32 + sr) * LDK + sc]); } while (0)
#define SWRITE(b, i) do { *(bf16x8*)((char*)V_lds + (b) * SHM_V + vst0) = sr_[i].vs0;          \
    *(bf16x8*)((char*)V_lds + (b) * SHM_V + vst1) = sr_[i].vs1; int kc = sc * 2;               \
    *(bf16x8*)((char*)K_lds + (b) * SHM_K + KSWZ(sr, kc)) = sr_[i].ks0;                       \
    *(bf16x8*)((char*)K_lds + (b) * SHM_K + KSWZ(32 + sr, kc)) = sr_[i].ks1; } while (0)
#define SWAIT() asm volatile("s_waitcnt vmcnt(4)" ::: "memory")
#define RESC(a) do { if (__any((a) < 1.f)) { if (hi == 0) al_l[r32] = (a); asm volatile("s_waitcnt lgkmcnt(0)" ::: "memory"); \
    for (int d = 0; d < 4; ++d) for (int r = 0; r < 16; ++r) o[d][r] *= al_l[crow(r, hi)]; } } while (0)
  f32x16 pA0, pA1, pB0, pB1; float mnA, mnB, alA, alB; bf16x8 pa0, pa1, pa2, pa3; const int NT = seq / KVBLK;
  constexpr int SE = 0, SO = SDEPTH - 1;
  SLOAD(SE, 0); asm volatile("s_waitcnt vmcnt(0)" ::: "memory"); SWRITE(0, SE); __syncthreads();
  qkt(pA0, pA1, K_lds, qr, r32, hi); partialSM(pA0, pA1, m_reg, mnA, alA);
  SLOAD(SO, KVBLK); if (2 < NT) SLOAD(SE, 2 * KVBLK);
  SWAIT(); SWRITE(1, SO); __syncthreads();
  for (int j = 1; j + 1 < NT; j += 2) {
    SBAR(); qkt(pB0, pB1, (bf16*)((char*)K_lds + SHM_K), qr, r32, hi);
    finishSM(pA0, pA1, alA, l_reg, pa0, pa1, pa2, pa3); SBAR();
    SLOAD(SO, (j + SDEPTH) * KVBLK); SBAR();
    pv_d0(o, vb0, pa0, pa1, pa2, pa3); partialSM(pB0, pB1, m_reg, mnB, alB);
    __syncthreads(); SWAIT(); SWRITE(0, SE);
    RESC(alB); __syncthreads();
    SBAR(); qkt(pA0, pA1, K_lds, qr, r32, hi);
    finishSM(pB0, pB1, alB, l_reg, pa0, pa1, pa2, pa3); SBAR();
    if (j + 3 < NT) SLOAD(SE, (j + 1 + SDEPTH) * KVBLK); SBAR();
    pv_d0(o, vb0 + (int)SHM_V, pa0, pa1, pa2, pa3); partialSM(pA0, pA1, m_reg, mnA, alA);
    __syncthreads(); SWAIT(); SWRITE(1, SO);
    RESC(alA); __syncthreads();
  }
  SBAR(); qkt(pB0, pB1, (bf16*)((char*)K_lds + SHM_K), qr, r32, hi);
  finishSM(pA0, pA1, alA, l_reg, pa0, pa1, pa2, pa3); SBAR();
  pv_d0(o, vb0, pa0, pa1, pa2, pa3); partialSM(pB0, pB1, m_reg, mnB, alB);
  __syncthreads(); RESC(alB);
  finishSM(pB0, pB1, alB, l_reg, pa0, pa1, pa2, pa3); SBAR();
  pv_d0(o, vb0 + (int)SHM_V, pa0, pa1, pa2, pa3);
  if (hi == 0) li_l[r32] = l_reg; asm volatile("s_waitcnt lgkmcnt(0)" ::: "memory");
  float rli[16];
#pragma unroll
  for (int r = 0; r < 16; ++r) rli[r] = __builtin_amdgcn_rcpf(li_l[crow(r, hi)]);
  bf16* Ow = Ob + (long)(wid * QBLK) * LDO;
#pragma unroll
  for (int r = 0; r < 16; ++r) { int orow = crow(r, hi);
    for (int d0 = 0; d0 < 4; ++d0) { bf16* p = Ow + (long)orow * LDO + d0 * 32 + r32; const float g = __uint_as_float((unsigned)(*p) << 16); *p = (bf16)f2bf(o[d0][r] * rli[r] * g); } }
  __syncthreads();
#undef SLOAD
#undef SWRITE
#undef SWAIT
#undef RESC
}
#undef KSWZ
#undef SBAR
}
__device__ __forceinline__ void attn_phase_mfma(const Ctx& F, char* ldsg) {
    for (int u = F.bid; u < (MT / 256) * 4; u += F.G) {
        const int rb = u >> 2, h = u & 3, row0 = rb * 256, seq = row0 < MP ? row0 >> 11 : 16;
        const bf16_t* Kh = F.KV + (size_t)(seq * NMEM) * 1024 + h * 128;
        att::attn_unit(F.Q + (size_t)row0 * 512 + h * 128, Kh, Kh + 512, F.FO + (size_t)row0 * 1024 + 512 + h * 128, NMEM, ldsg);
    }
}
__device__ __forceinline__ void final_norm_phase(const Ctx& F) {
    const int gw = F.bid * NWAVES + F.wave, NGW = F.G * NWAVES;
    for (int m = gw; m < MT; m += NGW) {
        f32x4* xr = (f32x4*)(F.out + (size_t)m * DM) + F.lane; const f32x4* gr = (const f32x4*)F.norm_f + F.lane;
        f32x4 v[4]; float s = 0.f;
#pragma unroll
        for (int j = 0; j < 4; ++j) { v[j] = xr[64 * j]; s += (v[j].x * v[j].x + v[j].y * v[j].y) + (v[j].z * v[j].z + v[j].w * v[j].w); }
        const float r = 1.0f / sqrtf(wave_sum(s) * (1.f / DM) + EPS);
#pragma unroll
        for (int j = 0; j < 4; ++j) { const f32x4 g = gr[64 * j]; xr[64 * j] = v[j] * r * g; }
    }
}

struct Args { const float* in[17]; float* out; unsigned char* ws; int ph_lo, ph_hi; };
constexpr int N_PHASES = 7;
__global__ void __launch_bounds__(NTHR, 2) fwd(Args args) {
    extern __shared__ __attribute__((aligned(16))) unsigned char lds_[];
    Ctx F;
    F.lds = (LAS unsigned char*)lds_;
    F.tid = threadIdx.x; F.lane = F.tid & 63; F.wave = __builtin_amdgcn_readfirstlane(F.tid >> 6); F.G = gridDim.x; F.bid = blockIdx.x;
    F.xp = args.in[0]; F.xs = args.in[1]; F.memp = args.in[2]; F.mems = args.in[3]; F.norm_in = args.in[4]; F.norm_mem = args.in[5]; F.w_in = args.in[6]; F.w_pool_grp = args.in[7];
    F.pool_scale = args.in[8]; F.w_four_grp = args.in[9]; F.w_kv = args.in[10]; F.w_pool_out = args.in[11]; F.w_four_out = args.in[12]; F.w_attn_out = args.in[13]; F.b_gate = args.in[14];
    F.w_o = args.in[15]; F.norm_f = args.in[16]; F.out = args.out;
    unsigned char* ws = args.ws; unsigned char* ob = (unsigned char*)args.out;
    F.W1T = (bf16_t*)(ws + WS_W1T); F.WGT = (bf16_t*)(ws + WS_WGT); F.WPOT = (bf16_t*)(ws + WS_WPOT); F.WFAT = (bf16_t*)(ws + WS_WFAT); F.WOT = (bf16_t*)(ws + WS_WOT); F.WKVT = (bf16_t*)(ws + WS_WKVT);
    F.MN = (bf16_t*)(ws + WS_MN); F.KV = (bf16_t*)(ws + WS_KV); F.XN = (bf16_t*)(ws + WS_XN); F.PA = (bf16_t*)(ws + WS_PA); F.FO = (bf16_t*)(ws + WS_FO); F.AB = (bf16_t*)(ws + WS_AB);
    F.Q = (bf16_t*)(ws + WS_Q); F.PVF = (bf16_t*)(ob + OUT_PVF); F.Y1 = (bf16_t*)(ob + OUT_Y1); F.MERGED = (bf16_t*)(ws + WS_AB);
    F.TAB = (bf16_t*)(ws + WS_TAB);
    F.stash = ob + OUT_STASH + (size_t)blockIdx.x * 262144;
    if (F.tid < 128) { LAS f32x2* tab = (LAS f32x2*)(F.lds + TAB_OFF); f32x2 v; v.x = cospif((float)F.tid * (1.0f / 64.0f)); v.y = sinpif((float)F.tid * (1.0f / 64.0f)); tab[F.tid] = v; }
    if (F.tid < 64) ((LAS unsigned*)(F.lds + MISC_OFF))[F.tid] = 0u;
    __syncthreads();
    XcdBarrier bar = xcd_barrier_post((unsigned*)(ws + WS_CTL), (volatile LAS unsigned*)(F.lds + MISC_OFF) + 8);
    const int lo = args.ph_lo, hi = args.ph_hi;
#define IN(k) (lo <= (k) && (k) < hi)
#define SEAM(k) do { if (IN(k) && IN((k) + 1)) xcd_barrier(bar); } while (0)
    if (IN(0)) { for (int rep = 0; rep < REP_P0; ++rep) p0_prologue(F); }
    SEAM(0);
    if (IN(1)) {
        SchedP1 S{F.G, F.bid, (const char*)F.XN, (const char*)F.W1T, (const char*)F.MN, (const char*)F.WKVT};
        EpiP1 E{F.PVF, F.PA, F.AB, F.FO, F.Q, F.KV};
        for (int rep = 0; rep < REP_G; ++rep) pg8::gemm_phase<EpiP1, SchedP1, false, true>(F.lds, S, E);
    }
    SEAM(1);
    if (IN(2)) { pool_phase(F); dft1_mfma<128>(F, F.TAB, F.Y1); dft1_mfma<16>(F, F.TAB + TAB_E116, F.AB); attn_phase_mfma(F, (char*)lds_); }
    SEAM(2);
    if (IN(3)) { dft2_mfma(F, F.TAB + TAB_E2); }
    SEAM(3);
    if (IN(4)) {
        SchedP3 S{F.G, F.bid, (const char*)F.PA, (const char*)F.XN, (const char*)F.FO, (const char*)F.WPOT, (const char*)F.WGT, (const char*)F.WFAT};
        EpiP3 E{F.stash, F.b_gate, F.MERGED};
        for (int rep = 0; rep < REP_G; ++rep) pg8::gemm_phase<EpiP3, SchedP3, true, true>(F.lds, S, E);
    }
    SEAM(4);
    if (IN(5)) {
        SchedP4 S{F.G, F.bid, (const char*)F.MERGED, (const char*)F.WOT};
        EpiP4 E{F.xp, F.xs, F.out};
        for (int rep = 0; rep < REP_G; ++rep) pg8::gemm_phase<EpiP4, SchedP4, true, true>(F.lds, S, E);
    }
    SEAM(5);
    if (IN(6)) { final_norm_phase(F); }
#undef IN
#undef SEAM
}

extern "C" void kernel_launch(void* const* d_in, const int* in_sizes, int n_in, void* d_out, int out_size, void* d_ws, size_t ws_size, hipStream_t stream) {
    static int grid = 0;
    if (grid == 0) {
        if (n_in != 17 || in_sizes[0] != MP * DM || in_sizes[1] != MS * DM || out_size != MT * DM || ws_size < WS_END) {
            fprintf(stderr, "kernel_launch: unexpected shapes: n_in %d in0 %d in1 %d out %d ws %zu (need %zu); nothing launched\n", n_in, n_in > 0 ? in_sizes[0] : -1, n_in > 1 ? in_sizes[1] : -1, out_size, ws_size, (size_t)WS_END);
            grid = -1; return; }
        int dev = 0, cus = 0, per_cu = 0;
        if (hipGetDevice(&dev) != hipSuccess || hipDeviceGetAttribute(&cus, hipDeviceAttributeMultiprocessorCount, dev) != hipSuccess) { grid = -1; return; }
        if (hipFuncSetAttribute((const void*)fwd, hipFuncAttributeMaxDynamicSharedMemorySize, LDS_BYTES) != hipSuccess) { fprintf(stderr, "kernel_launch: hipFuncSetAttribute failed\n"); grid = -1; return; }
        if (hipOccupancyMaxActiveBlocksPerMultiprocessor(&per_cu, (const void*)fwd, NTHR, LDS_BYTES) != hipSuccess || per_cu < 1) { fprintf(stderr, "kernel_launch: occupancy query says %d\n", per_cu); per_cu = 1; }
        (void)hipGetLastError();
        grid = cus;
        if (grid > 256) grid = 256;
    }
    if (grid < 0) return;
    if (hipMemsetAsync((char*)d_ws + WS_CTL, 0, CTL_ZERO_BYTES, stream) != hipSuccess) { fprintf(stderr, "kernel_launch: memset failed\n"); return; }
    Args a{};
    for (int i = 0; i < 17; ++i) a.in[i] = (const float*)d_in[i];
    a.out = (float*)d_out; a.ws = (unsigned char*)d_ws;
#if MK_FUSED
    a.ph_lo = 0; a.ph_hi = N_PHASES;
    void* kargs[] = {&a};
    hipError_t e = hipLaunchCooperativeKernel((const void*)fwd, dim3(grid), dim3(NTHR), kargs, LDS_BYTES, stream);
    if (e != hipSuccess) fprintf(stderr, "kernel_launch: cooperative launch failed: %s (grid %d)\n", hipGetErrorString(e), grid);
#else
    for (int p = 0; p < N_PHASES; ++p) {
        a.ph_lo = p; a.ph_hi = p + 1;
        hipLaunchKernelGGL(fwd, dim3(grid), dim3(NTHR), LDS_BYTES, stream, a);
        const hipError_t le = hipPeekAtLastError();
        if (le != hipSuccess) { fprintf(stderr, "kernel_launch: launch %d failed: %s\n", p, hipGetErrorName(le)); break; }
    }
#endif
}
```
